# Optimizing an MI355X kernel written in HIP

```python
import math
import jax, jax.numpy as jnp
from jax import lax
import numpy as np

D_MODEL = 2048
BATCH = 4
SEQ = 4096
DEPTH = 1

MEM_LEN = 256
EPS = 1e-6
SGU_HEADS = 8
SGU_DIM = 128
SGU_CHUNK = 128
SGU_WIDTH = SGU_HEADS * SGU_DIM
DIFF_HEADS = 8
DIFF_QK_DIM = 64
DIFF_V_DIM = 128
DIFF_WIDTH = DIFF_HEADS * DIFF_V_DIM
DIFF_QK_WIDTH = DIFF_HEADS * 2 * DIFF_QK_DIM
Q_BLOCK = 128
MIX_WIDTH = SGU_WIDTH + DIFF_WIDTH
IN_WIDTH = 2 * SGU_WIDTH + 2 * DIFF_QK_WIDTH + DIFF_WIDTH
REL_BUCKETS = 32
REL_MAX_DIST = 128
CROSS_HEADS = 4
CROSS_HEAD_DIM = D_MODEL // CROSS_HEADS
PEER_HEADS = 8
PEER_NKEYS = 128
PEER_N_EXPERTS = PEER_NKEYS * PEER_NKEYS
PEER_QDIM = 256
PEER_HALF = PEER_QDIM // 2
PEER_TOPK = 16
PEER_CHUNK = 128

kernel_name = "hybrid_sgu_diffattn_peer_layer"


def rmsnorm(x, g):
    xf = x.astype(jnp.float32)
    y = xf * lax.rsqrt(jnp.mean(xf * xf, axis=-1, keepdims=True) + EPS)
    return (y * g.astype(jnp.float32)).astype(x.dtype)


def t5_bucket(n):
    max_exact = REL_BUCKETS // 2
    nf = jnp.maximum(n, 1).astype(jnp.float32)
    large = max_exact + (jnp.log(nf / max_exact) / math.log(REL_MAX_DIST / max_exact)
                         * (REL_BUCKETS - max_exact)).astype(jnp.int32)
    large = jnp.minimum(large, REL_BUCKETS - 1)
    return jnp.where(n < max_exact, n, large)


def spatial_gating(u, v, norm_g, w_s, b_s):
    B, S = u.shape[0], u.shape[1]
    vn = rmsnorm(v, norm_g)
    vc = vn.reshape(B, S // SGU_CHUNK, SGU_CHUNK, SGU_HEADS, SGU_DIM)
    mask = jnp.tril(jnp.ones((SGU_CHUNK, SGU_CHUNK), w_s.dtype))
    mixed = jnp.einsum('hpq,bnqhc->bnphc', w_s * mask, vc) + b_s.T[None, None, :, :, None]
    return u * mixed.reshape(B, S, SGU_HEADS, SGU_DIM)


def diff_attention(q, k, v, lam, rel_bias):
    B, S = q.shape[0], q.shape[1]
    qh = q.transpose(0, 2, 3, 1, 4)
    kh = k.transpose(0, 2, 3, 1, 4)
    vh = v.transpose(0, 2, 1, 3)
    kpos = jnp.arange(S)
    scale = DIFF_QK_DIM ** -0.5

    def block(i):
        start = i * Q_BLOCK
        qb = lax.dynamic_slice_in_dim(qh, start, Q_BLOCK, axis=3)
        dist = (start + jnp.arange(Q_BLOCK))[:, None] - kpos[None, :]
        bias = rel_bias[t5_bucket(jnp.maximum(dist, 0))].transpose(2, 0, 1)
        logits = (jnp.einsum('bhcqd,bhckd->bhcqk', qb, kh).astype(jnp.float32) * scale
                  + bias[None, :, None].astype(jnp.float32))
        logits = jnp.where((dist >= 0)[None, None, None], logits, -jnp.inf)
        p = jax.nn.softmax(logits, axis=-1)
        a = p[:, :, 0] - lam * p[:, :, 1]
        return jnp.einsum('bhqk,bhkd->bhqd', a.astype(vh.dtype), vh)

    out = lax.map(block, jnp.arange(S // Q_BLOCK))
    return out.transpose(1, 0, 3, 2, 4).reshape(B, S, DIFF_HEADS, DIFF_V_DIM)


def cross_attention(h, memn, w_q, w_kv, qg, kg, w_o):
    B, S = h.shape[0], h.shape[1]
    M = memn.shape[1]
    q = rmsnorm((h @ w_q).reshape(B, S, CROSS_HEADS, CROSS_HEAD_DIM), qg)
    kv = (memn @ w_kv).reshape(B, M, 2, CROSS_HEADS, CROSS_HEAD_DIM)
    k = rmsnorm(kv[:, :, 0], kg)
    v = kv[:, :, 1]
    logits = jnp.einsum('bshd,bmhd->bhsm', q, k).astype(jnp.float32) * (CROSS_HEAD_DIM ** -0.5)
    p = jax.nn.softmax(logits, axis=-1)
    o = jnp.einsum('bhsm,bmhd->bshd', p.astype(v.dtype), v)
    return o.reshape(B, S, D_MODEL) @ w_o


def peer(h, w_q, keys, U, V):
    B, S, D = h.shape
    T = B * S
    hf = h.reshape(T, D)
    q = (hf @ w_q).reshape(T, PEER_HEADS, 2, PEER_HALF)
    sub = jnp.einsum('thcd,hckd->thck', q, keys).astype(jnp.float32)
    s, i = lax.top_k(sub, PEER_TOPK)
    cand_s = (s[:, :, 0, :, None] + s[:, :, 1, None, :]).reshape(T, PEER_HEADS, PEER_TOPK * PEER_TOPK)
    cand_i = (i[:, :, 0, :, None] * PEER_NKEYS + i[:, :, 1, None, :]).reshape(T, PEER_HEADS, PEER_TOPK * PEER_TOPK)
    top_s, pos = lax.top_k(cand_s, PEER_TOPK)
    idx = jnp.take_along_axis(cand_i, pos, axis=-1)
    g = jax.nn.softmax(top_s, axis=-1)
    nc = T // PEER_CHUNK

    def chunk(args):
        xc, ic, gc = args
        u = jnp.take(U, ic, axis=0)
        a = jnp.einsum('cd,chkd->chk', xc, u)
        coeff = (gc * jax.nn.gelu(a.astype(jnp.float32), approximate=False)).astype(xc.dtype)
        vv = jnp.take(V, ic, axis=0)
        return jnp.einsum('chk,chkd->cd', coeff, vv)

    out = lax.map(chunk, (hf.reshape(nc, PEER_CHUNK, D),
                          idx.reshape(nc, PEER_CHUNK, PEER_HEADS, PEER_TOPK),
                          g.reshape(nc, PEER_CHUNK, PEER_HEADS, PEER_TOPK)))
    return out.reshape(B, S, D)


def setup_inputs(seed: int = 0) -> dict:
    key = jax.random.key(seed)
    ks = jax.random.split(key, 32)
    f32 = jnp.float32
    L = DEPTH

    def nrm(k, shape, scale):
        return jax.random.normal(k, shape, f32) * scale

    def gain(k, shape):
        return 1.0 + 0.02 * jax.random.normal(k, shape, f32)

    return {
        "x": nrm(ks[0], (BATCH, SEQ, D_MODEL), 1.0),
        "mem": nrm(ks[1], (BATCH, MEM_LEN, D_MODEL), 1.0),
        "norm_mix_g": gain(ks[2], (L, D_MODEL)),
        "w_in": nrm(ks[3], (L, D_MODEL, IN_WIDTH), D_MODEL ** -0.5),
        "sgu_norm_g": gain(ks[4], (L, SGU_HEADS, SGU_DIM)),
        "sgu_w": nrm(ks[5], (L, SGU_HEADS, SGU_CHUNK, SGU_CHUNK), SGU_CHUNK ** -0.5),
        "sgu_b": gain(ks[6], (L, SGU_HEADS, SGU_CHUNK)),
        "q_norm_g": gain(ks[7], (L, DIFF_QK_DIM)),
        "k_norm_g": gain(ks[8], (L, DIFF_QK_DIM)),
        "lambda_q1": nrm(ks[9], (L, DIFF_QK_DIM), 0.1),
        "lambda_k1": nrm(ks[10], (L, DIFF_QK_DIM), 0.1),
        "lambda_q2": nrm(ks[11], (L, DIFF_QK_DIM), 0.1),
        "lambda_k2": nrm(ks[12], (L, DIFF_QK_DIM), 0.1),
        "diff_subln_g": gain(ks[13], (L, DIFF_V_DIM)),
        "rel_bias": nrm(ks[14], (REL_BUCKETS, DIFF_HEADS), 0.5),
        "w_out": nrm(ks[15], (L, MIX_WIDTH, D_MODEL), MIX_WIDTH ** -0.5),
        "norm_cross_g": gain(ks[16], (L, D_MODEL)),
        "norm_mem_g": gain(ks[17], (L, D_MODEL)),
        "w_cq": nrm(ks[18], (L, D_MODEL, D_MODEL), D_MODEL ** -0.5),
        "w_ckv": nrm(ks[19], (L, D_MODEL, 2 * D_MODEL), D_MODEL ** -0.5),
        "cq_norm_g": gain(ks[20], (L, CROSS_HEAD_DIM)),
        "ck_norm_g": gain(ks[21], (L, CROSS_HEAD_DIM)),
        "w_co": nrm(ks[22], (L, D_MODEL, D_MODEL), D_MODEL ** -0.5),
        "norm_ffn_g": gain(ks[23], (L, D_MODEL)),
        "peer_wq": nrm(ks[24], (L, D_MODEL, PEER_HEADS * PEER_QDIM), D_MODEL ** -0.5),
        "peer_keys": nrm(ks[25], (L, PEER_HEADS, 2, PEER_NKEYS, PEER_HALF), PEER_HALF ** -0.5),
        "peer_u": nrm(ks[26], (L, PEER_N_EXPERTS, D_MODEL), D_MODEL ** -0.5),
        "peer_v": nrm(ks[27], (L, PEER_N_EXPERTS, D_MODEL), 0.5),
    }


def reference(x, mem, norm_mix_g, w_in, sgu_norm_g, sgu_w, sgu_b, q_norm_g, k_norm_g,
              lambda_q1, lambda_k1, lambda_q2, lambda_k2, diff_subln_g, rel_bias, w_out,
              norm_cross_g, norm_mem_g, w_cq, w_ckv, cq_norm_g, ck_norm_g, w_co,
              norm_ffn_g, peer_wq, peer_keys, peer_u, peer_v):
    B, S, _ = x.shape
    h = x
    a0 = 2 * SGU_WIDTH
    a1 = a0 + DIFF_QK_WIDTH
    a2 = a1 + DIFF_QK_WIDTH
    for l in range(DEPTH):
        lam_init = 0.8 - 0.6 * math.exp(-0.3 * l)
        hn = rmsnorm(h, norm_mix_g[l])
        z = hn @ w_in[l]
        zs = jax.nn.gelu(z[..., :a0].astype(jnp.float32), approximate=False).astype(z.dtype)
        u = zs[..., :SGU_WIDTH].reshape(B, S, SGU_HEADS, SGU_DIM)
        v = zs[..., SGU_WIDTH:].reshape(B, S, SGU_HEADS, SGU_DIM)
        out_sgu = spatial_gating(u, v, sgu_norm_g[l], sgu_w[l], sgu_b[l])

        q = rmsnorm(z[..., a0:a1].reshape(B, S, DIFF_HEADS, 2, DIFF_QK_DIM), q_norm_g[l])
        k = rmsnorm(z[..., a1:a2].reshape(B, S, DIFF_HEADS, 2, DIFF_QK_DIM), k_norm_g[l])
        vd = z[..., a2:].reshape(B, S, DIFF_HEADS, DIFF_V_DIM)
        lam = (jnp.exp(jnp.sum(lambda_q1[l].astype(jnp.float32) * lambda_k1[l].astype(jnp.float32)))
               - jnp.exp(jnp.sum(lambda_q2[l].astype(jnp.float32) * lambda_k2[l].astype(jnp.float32)))
               + lam_init)
        out_diff = diff_attention(q, k, vd, lam, rel_bias)
        out_diff = rmsnorm(out_diff, diff_subln_g[l]) * (1.0 - lam_init)

        mix = jnp.concatenate([out_sgu.reshape(B, S, SGU_WIDTH),
                               out_diff.reshape(B, S, DIFF_WIDTH)], axis=-1) @ w_out[l]
        h = h + mix
        h = h + cross_attention(rmsnorm(h, norm_cross_g[l]), rmsnorm(mem, norm_mem_g[l]),
                                w_cq[l], w_ckv[l], cq_norm_g[l], ck_norm_g[l], w_co[l])
        h = h + peer(rmsnorm(h, norm_ffn_g[l]), peer_wq[l], peer_keys[l], peer_u[l], peer_v[l])
    return h
```

```cpp
#include <hip/hip_runtime.h>
#include <cstdio>
#include <cstdint>

#ifndef MK_SPLIT
#define MK_SPLIT 0
#endif
#ifndef DUP_SUB
#define DUP_SUB 0
#endif
#ifndef DUP_PHASE
#define DUP_PHASE -1
#endif

#define LAS __attribute__((address_space(3)))
#define GAS __attribute__((address_space(1)))
typedef unsigned short bf16_t;
typedef short bf16x8 __attribute__((ext_vector_type(8)));
typedef float f32x2 __attribute__((ext_vector_type(2)));
typedef float f32x4 __attribute__((ext_vector_type(4)));
typedef float f32x16 __attribute__((ext_vector_type(16)));
typedef unsigned u32x2 __attribute__((ext_vector_type(2)));
typedef unsigned u32x4 __attribute__((ext_vector_type(4)));
typedef unsigned long long u64;

constexpr int NB = 4, SEQ = 4096, T = NB * SEQ, D = 2048, MEML = 256, MROWS = NB * MEML;
constexpr float EPS = 1e-6f, LOG2E = 1.4426950408889634f;
constexpr float FX = 1048576.0f, FXI = 1.0f / 1048576.0f;

constexpr size_t MiB = 1u << 20;
constexpr size_t WS_CTL = 0, CTL_BYTES = 2 * MiB;
constexpr size_t WS_WIN = 2 * MiB, WS_WOUT = 22 * MiB, WS_WCQ = 30 * MiB, WS_WCKV = 38 * MiB, WS_WCO = 54 * MiB, WS_WPQ = 62 * MiB;
constexpr size_t WS_KEYS = 70 * MiB, WS_SGUW = 70 * MiB + 512 * 1024, WS_MISC = 71 * MiB;
constexpr size_t WS_MEMN = 72 * MiB, WS_KC = 76 * MiB, WS_VCT = 80 * MiB, WS_LPART = 84 * MiB;
constexpr size_t WS_XN = 86 * MiB;
constexpr size_t WS_Z = 150 * MiB;
constexpr size_t WS_QC = WS_Z, WS_PC = WS_Z + 64 * MiB, WS_QP = WS_Z, WS_H8 = WS_Z + 96 * MiB;
constexpr size_t WS_VT = 278 * MiB;
constexpr size_t WS_MIX = 310 * MiB;
constexpr size_t WS_U8 = 374 * MiB, WS_V8 = 406 * MiB, WS_END = 438 * MiB;
constexpr size_t WS_USC = WS_MISC + 256 * 1024, WS_VSC = WS_MISC + 320 * 1024;
constexpr int CW_BAR = 4096;
constexpr size_t CB_SSQ1 = 64 * 1024, CB_SSQ2 = 192 * 1024, CB_SSQK = 320 * 1024, CB_SSQQ = 512 * 1024;

constexpr int RING_BYTES = 131072, MISC_OFF = RING_BYTES + 320, LDS_BYTES = 163840;

__device__ __forceinline__ unsigned f2bf(float f) { unsigned u = __builtin_bit_cast(unsigned, f); return (u + 0x7fffu + ((u >> 16) & 1u)) >> 16; }
__device__ __forceinline__ unsigned pk2(float lo, float hi) { return f2bf(lo) | (f2bf(hi) << 16); }
__device__ __forceinline__ float bflo(unsigned w) { return __builtin_bit_cast(float, w << 16); }
__device__ __forceinline__ float bfhi(unsigned w) { return __builtin_bit_cast(float, w & 0xffff0000u); }
__device__ __forceinline__ unsigned cvt_pk_bf16(float lo, float hi) { unsigned r; asm volatile("v_cvt_pk_bf16_f32 %0, %1, %2" : "=v"(r) : "v"(lo), "v"(hi)); return r; }
__device__ __forceinline__ float wave_sum(float v) {
#pragma unroll
    for (int o = 1; o < 64; o <<= 1) v += __shfl_xor(v, o);
    return v;
}
__device__ __forceinline__ float wave_max(float v) {
#pragma unroll
    for (int o = 1; o < 64; o <<= 1) v = fmaxf(v, __shfl_xor(v, o));
    return v;
}
__device__ __forceinline__ float stat_rstd(u64 s, float inv_n) { return 1.0f / sqrtf((float)s * FXI * inv_n + EPS); }
__device__ __forceinline__ void stat_add(u64* p, float v) { __hip_atomic_fetch_add(p, (u64)(v * FX + 0.5f), __ATOMIC_RELAXED, __HIP_MEMORY_SCOPE_AGENT); }

__device__ __forceinline__ u32x2 pack8_fp8(f32x4 a, f32x4 b) {
#pragma unroll
    for (int i = 0; i < 4; ++i) { a[i] = __builtin_amdgcn_fmed3f(a[i], -448.0f, 448.0f); b[i] = __builtin_amdgcn_fmed3f(b[i], -448.0f, 448.0f); }
    int lo = __builtin_amdgcn_cvt_pk_fp8_f32(a[0], a[1], 0, false); lo = __builtin_amdgcn_cvt_pk_fp8_f32(a[2], a[3], lo, true);
    int hi = __builtin_amdgcn_cvt_pk_fp8_f32(b[0], b[1], 0, false); hi = __builtin_amdgcn_cvt_pk_fp8_f32(b[2], b[3], hi, true);
    return (u32x2){(unsigned)lo, (unsigned)hi};
}
constexpr float XU_SCALE = 16.0f;
constexpr float W8_SCALE = 2048.0f, A8_SCALE = 16.0f, OC8_SCALE = 64.0f;

__device__ __forceinline__ void glds16s(const void* sbase, unsigned voff, unsigned lds_dst) { unsigned keep;
    asm volatile("s_mov_b32 %0, m0\n\ts_mov_b32 m0, %3\n\ts_nop 0\n\tglobal_load_lds_dwordx4 %1, %2\n\ts_mov_b32 m0, %0" : "=&s"(keep) : "v"(voff), "s"(sbase), "s"(lds_dst) : "memory"); }

namespace pg8 {
constexpr int BM = 256, BK = 64, HALF = 128, HTB = HALF * BK * 2, STAGE_BYTES = 8 * HTB, NXCD = 8, WGM = 8;
__host__ __device__ __forceinline__ int lds_byte(int r, int c) { const int st = (r >> 4) * 2 + (c >> 5), rr = r & 15, cc = c & 31, ob = rr * 64 + cc * 2; return st * 1024 + (ob ^ (((ob >> 9) & 1) << 5)); }
__host__ __device__ __forceinline__ void stage_rc(int b, int& R, int& C) { const int st = b / 1024, sb = b % 1024, swz = sb ^ (((sb >> 9) & 1) << 5); R = (st >> 1) * 16 + swz / 64; C = (st & 1) * 32 + (swz % 64) / 2; }
__host__ __device__ __forceinline__ int perm32(int rho) { const int n = rho >> 4, i = rho & 15; return 8 * (i >> 2) + 4 * n + (i & 3); }

typedef int i32x8_t __attribute__((ext_vector_type(8)));
typedef short bf16x16_t __attribute__((ext_vector_type(16)));
struct Unit { const char* a; const char* b; int pm, pn, z; };
struct Gemm { int lda, ldb, K; };

struct PlainOrder {
    const char* A; const char* Bt; int lda, ldb, nM, nN, nwg, G, c;
    __device__ void init(const void* A_, const void* Bt_, int lda_, int ldb_, int M, int N, int G_, int c_) { A = (const char*)A_; Bt = (const char*)Bt_; lda = lda_; ldb = ldb_; nM = M / BM; nN = N / BM; nwg = nM * nN; G = G_; c = c_; }
    __device__ bool next(int i, Unit& u) const {
        const long L = (long)i * G + c; if (L >= nwg) return false;
        int wgid = (int)L; { const int q = nwg / NXCD, r = nwg % NXCD, xcd = wgid % NXCD, off = wgid / NXCD; wgid = (xcd < r ? xcd * (q + 1) : r * (q + 1) + (xcd - r) * q) + off; }
        const int nig = WGM * nN, gid = wgid / nig, fm = gid * WGM, gsz = (nM - fm) < WGM ? (nM - fm) : WGM;
        u.pm = fm + ((wgid % nig) % gsz); u.pn = (wgid % nig) / gsz; u.z = 0;
        u.a = A + (size_t)u.pm * BM * lda * 2; u.b = Bt + (size_t)u.pn * BM * ldb * 2; return true;
    }
    __device__ __forceinline__ void a_ready(const Unit&) const {}
    __device__ __forceinline__ void done(const Unit&) const {}
};
struct BatchOrder {
    const char* A; const char* Bt; int lda, ldb, nM, nN, nwg, G, v; size_t sAb, sAh, sBb, sBh;
    __device__ bool next(int i, Unit& u) const {
        const long L = (long)i * G + v; if (L >= nwg) return false;
        const int per = nM * nN, z = (int)L / per, rem = (int)L % per;
        u.z = z; u.pm = rem / nN; u.pn = rem % nN;
        u.a = A + (size_t)(z >> 2) * sAb + (size_t)(z & 3) * sAh + (size_t)u.pm * BM * lda * 2;
        u.b = Bt + (size_t)(z >> 2) * sBb + (size_t)(z & 3) * sBh + (size_t)u.pn * BM * ldb * 2; return true;
    }
    __device__ __forceinline__ void a_ready(const Unit&) const {}
    __device__ __forceinline__ void done(const Unit&) const {}
};
struct PairOrder {
    const char *A0, *B0, *A1, *B1; int lda, ldb, nM0, nN0, nM1, nN1, G, v;
    __device__ bool next(int i, Unit& u) const {
        const int L = i * G + v; const int n0 = nM0 * nN0, n1 = nM1 * nN1; if (L >= n0 + n1) return false;
        if (L < n0) { u.z = 0; u.pm = L / nN0; u.pn = L % nN0; u.a = A0 + (size_t)u.pm * BM * lda * 2; u.b = B0 + (size_t)u.pn * BM * ldb * 2; }
        else { const int r = L - n0; u.z = 1; u.pm = r / nN1; u.pn = r % nN1; u.a = A1 + (size_t)u.pm * BM * lda * 2; u.b = B1 + (size_t)u.pn * BM * ldb * 2; }
        return true;
    }
    __device__ __forceinline__ void a_ready(const Unit&) const {}
    __device__ __forceinline__ void done(const Unit&) const {}
};

__device__ __forceinline__ f32x2 gelu_pk(f32x2 v) {
    const f32x2 av = __builtin_elementwise_abs(v), d = av * 0.2316418882f + 1.0f;
    f32x2 t; t.x = __builtin_amdgcn_rcpf(d.x); t.y = __builtin_amdgcn_rcpf(d.y);
    f32x2 q = t * 0.5307027145f + (-0.7265760135f); q = q * t + 0.7107068705f; q = q * t + (-0.142248368f); q = q * t + 0.127414796f; q = q * t;
    const f32x2 s = (v * v) * (-0.72134752044f);
    f32x2 e; e.x = __builtin_amdgcn_exp2f(s.x); e.y = __builtin_amdgcn_exp2f(s.y);
    const f32x2 m = v * (q * e), r = v - m;
    f32x2 o; o.x = v.x < 0.f ? m.x : r.x; o.y = v.y < 0.f ? m.y : r.y; return o;
}
__device__ __forceinline__ f32x4 gelu4(f32x4 v) { const f32x2 a = gelu_pk((f32x2){v[0], v[1]}), b = gelu_pk((f32x2){v[2], v[3]}); return (f32x4){a.x, a.y, b.x, b.y}; }

template <bool GELU, bool COLS, bool ROWS, bool SSQ> struct EpiB {
    static constexpr bool PERM = true;
    bf16_t* O; int ldc; int gelu_pn; const float* cs; int cmask; const u64* rssq; float r_inv_n; u64* ssq; int nh; int tph; float oscale = 1.0f;
    __device__ __forceinline__ void operator()(const f32x4 (&acc)[2][2][4][2], const Unit& u, int wr, int wc, int fr, int fq) const {
        const int row0 = u.pm * BM + wr * 64 + fr, col0 = u.pn * BM + wc * 32 + 8 * fq;
        const bool dog = GELU && (u.pn < gelu_pn);
        f32x4 cv[2][2];
        if (COLS) {
#pragma unroll
            for (int bj = 0; bj < 2; ++bj)
#pragma unroll
                for (int n = 0; n < 2; ++n) cv[bj][n] = *(const f32x4*)(cs + ((col0 + bj * HALF + 4 * n) & cmask));
        }
#pragma unroll
        for (int ai = 0; ai < 2; ++ai)
#pragma unroll
            for (int m = 0; m < 4; ++m) {
                const int row = row0 + ai * HALF + m * 16; bf16_t* rowp = O + (size_t)row * ldc + col0;
                float rs = 1.f; if (ROWS) rs = stat_rstd(rssq[row], r_inv_n);
                float s = 0.f;
#pragma unroll
                for (int bj = 0; bj < 2; ++bj) { f32x4 v0 = acc[ai][bj][m][0] * oscale, v1 = acc[ai][bj][m][1] * oscale;
                    if (SSQ) s += (v0[0] * v0[0] + v0[1] * v0[1]) + (v0[2] * v0[2] + v0[3] * v0[3]) + (v1[0] * v1[0] + v1[1] * v1[1]) + (v1[2] * v1[2] + v1[3] * v1[3]);
                    if (GELU) { if (dog) { v0 = gelu4(v0); v1 = gelu4(v1); } }
                    if (COLS) { v0 = v0 * cv[bj][0]; v1 = v1 * cv[bj][1]; }
                    if (ROWS) { v0 = v0 * rs; v1 = v1 * rs; }
                    u32x4 w; w.x = cvt_pk_bf16(v0[0], v0[1]); w.y = cvt_pk_bf16(v0[2], v0[3]); w.z = cvt_pk_bf16(v1[0], v1[1]); w.w = cvt_pk_bf16(v1[2], v1[3]);
                    *(u32x4*)(rowp + bj * HALF) = w; }
                if (SSQ) { s += __shfl_xor(s, 16); s += __shfl_xor(s, 32); if (fq == 0) stat_add(ssq + (size_t)row * nh + u.pn / tph, s); }
            }
    }
};
struct EpiKV {
    static constexpr bool PERM = true;
    bf16_t* KC; bf16_t* VCT; const float* kgqg; u64* ssqk;
    __device__ __forceinline__ void operator()(const f32x4 (&acc)[2][2][4][2], const Unit& u, int wr, int wc, int fr, int fq) const {
        const int row0 = u.pm * BM + wr * 64 + fr, col0 = u.pn * BM + wc * 32 + 8 * fq;
        if (u.z == 0) { EpiB<false, true, false, true> e{KC, D, 0, kgqg, 511, nullptr, 0.f, ssqk, 4, 2}; e(acc, u, wr, wc, fr, fq); }
        else { EpiB<false, false, false, false> e{VCT, MROWS, 0, nullptr, 0, nullptr, 0.f, nullptr, 0, 1}; e(acc, u, wr, wc, fr, fq); }
        (void)row0; (void)col0;
    }
};
template <bool XF32> struct EpiH {
    static constexpr bool PERM = true;
    const void* base; bf16_t* H; u64* ssq; float accscale; unsigned char* H8 = nullptr;
    __device__ __forceinline__ void operator()(const f32x4 (&acc)[2][2][4][2], const Unit& u, int wr, int wc, int fr, int fq) const {
        const int row0 = u.pm * BM + wr * 64 + fr, col0 = u.pn * BM + wc * 32 + 8 * fq;
#pragma unroll
        for (int ai = 0; ai < 2; ++ai)
#pragma unroll
            for (int m = 0; m < 4; ++m) {
                const int row = row0 + ai * HALF + m * 16; const size_t off = (size_t)row * D + col0; float s = 0.f;
#pragma unroll
                for (int bj = 0; bj < 2; ++bj) {
                    f32x4 b0, b1;
                    if (XF32) { const float* xp = (const float*)base + off + bj * HALF; b0 = *(const f32x4*)xp; b1 = *(const f32x4*)(xp + 4); }
                    else { const u32x4 w = *(const u32x4*)((const bf16_t*)base + off + bj * HALF); b0 = (f32x4){bflo(w.x), bfhi(w.x), bflo(w.y), bfhi(w.y)}; b1 = (f32x4){bflo(w.z), bfhi(w.z), bflo(w.w), bfhi(w.w)}; }
                    const f32x4 h0 = b0 + acc[ai][bj][m][0] * accscale, h1 = b1 + acc[ai][bj][m][1] * accscale;
                    s += (h0[0] * h0[0] + h0[1] * h0[1]) + (h0[2] * h0[2] + h0[3] * h0[3]) + (h1[0] * h1[0] + h1[1] * h1[1]) + (h1[2] * h1[2] + h1[3] * h1[3]);
                    u32x4 o; o.x = cvt_pk_bf16(h0[0], h0[1]); o.y = cvt_pk_bf16(h0[2], h0[3]); o.z = cvt_pk_bf16(h1[0], h1[1]); o.w = cvt_pk_bf16(h1[2], h1[3]);
                    *(u32x4*)(H + off + bj * HALF) = o;
                    if (H8) *(u32x2*)(H8 + off + bj * HALF) = pack8_fp8(h0 * A8_SCALE, h1 * A8_SCALE); }
                s += __shfl_xor(s, 16); s += __shfl_xor(s, 32); if (fq == 0) stat_add(ssq + row, s);
                asm volatile("" ::: "memory");
            }
    }
};
struct EpiS {
    static constexpr bool PERM = true;
    bf16_t* P; const u64* ssq1; const u64* ssqq; const u64* ssqk; float* lpart; float cshift;
    __device__ __forceinline__ void operator()(const f32x4 (&acc)[2][2][4][2], const Unit& u, int wr, int wc, int fr, int fq) const {
        const int b = u.z >> 2, h = u.z & 3;
        const int row0 = b * SEQ + u.pm * BM + wr * 64 + fr, key0 = wc * 32 + 8 * fq;
        float fk[2][2][4];
#pragma unroll
        for (int bj = 0; bj < 2; ++bj)
#pragma unroll
            for (int n = 0; n < 2; ++n)
#pragma unroll
                for (int e = 0; e < 4; ++e) fk[bj][n][e] = stat_rstd(ssqk[(size_t)(b * MEML + key0 + bj * HALF + 4 * n + e) * 4 + h], 1.0f / 512.0f);
#pragma unroll
        for (int ai = 0; ai < 2; ++ai)
#pragma unroll
            for (int m = 0; m < 4; ++m) {
                const int row = row0 + ai * HALF + m * 16;
                const float r1 = stat_rstd(ssq1[row], 1.0f / 2048.0f);
                const float sq = (float)ssqq[(size_t)row * 4 + h] * FXI;
                const float rq = 1.0f / sqrtf(r1 * r1 * sq * (1.0f / 512.0f) + EPS);
                const float fr_ = r1 * rq * (0.044194173824159216f * LOG2E);
                float s = 0.f; bf16_t* rowp = P + (size_t)row * 1024 + h * 256 + key0;
#pragma unroll
                for (int bj = 0; bj < 2; ++bj) { float p[8];
#pragma unroll
                    for (int n = 0; n < 2; ++n)
#pragma unroll
                        for (int e = 0; e < 4; ++e) { p[4 * n + e] = __builtin_amdgcn_exp2f(acc[ai][bj][m][n][e] * fr_ * fk[bj][n][e] - cshift); s += p[4 * n + e]; }
                    u32x4 w; w.x = cvt_pk_bf16(p[0], p[1]); w.y = cvt_pk_bf16(p[2], p[3]); w.z = cvt_pk_bf16(p[4], p[5]); w.w = cvt_pk_bf16(p[6], p[7]);
                    *(u32x4*)(rowp + bj * HALF) = w; }
                s += __shfl_xor(s, 16); s += __shfl_xor(s, 32); if (fq == 0) lpart[((size_t)row * 4 + h) * 4 + wc] = s;
            }
    }
};
struct EpiPV {
    static constexpr bool PERM = true;
    unsigned char* O; const float* lpart;
    __device__ __forceinline__ void operator()(const f32x4 (&acc)[2][2][4][2], const Unit& u, int wr, int wc, int fr, int fq) const {
        const int b = u.z >> 2, h = u.z & 3;
        const int row0 = b * SEQ + u.pm * BM + wr * 64 + fr, col0 = h * 512 + u.pn * BM + wc * 32 + 8 * fq;
#pragma unroll
        for (int ai = 0; ai < 2; ++ai)
#pragma unroll
            for (int m = 0; m < 4; ++m) {
                const int row = row0 + ai * HALF + m * 16; const f32x4 lp = *(const f32x4*)(lpart + ((size_t)row * 4 + h) * 4);
                const float inv = OC8_SCALE / ((lp[0] + lp[1]) + (lp[2] + lp[3])); unsigned char* rowp = O + (size_t)row * D + col0;
#pragma unroll
                for (int bj = 0; bj < 2; ++bj) *(u32x2*)(rowp + bj * HALF) = pack8_fp8(acc[ai][bj][m][0] * inv, acc[ai][bj][m][1] * inv);
            }
    }
};

template <bool FP8 = false, class Epi, class Sched, bool ALIGN_EPI = true>
__device__ __forceinline__ void gemm_phase(LAS unsigned char* lds, const Gemm g, const Sched& S, const Epi& E) {
    const int tid = threadIdx.x, wid = __builtin_amdgcn_readfirstlane(tid >> 6), lane = tid & 63, wr = wid >> 2, wc = wid & 3, fr = lane & 15, fq = lane >> 4;
    const int K = g.K, nt = K / BK;
    unsigned voffA[2], voffB[2];
#pragma unroll
    for (int i = 0; i < 2; ++i) { int R, C; stage_rc(tid * 16 + i * 8192, R, C); const int Rb = Epi::PERM ? ((R & ~31) + perm32(R & 31)) : R;
        voffA[i] = (unsigned)(R * g.lda + C) * 2u; voffB[i] = (unsigned)(Rb * g.ldb + C) * 2u; }
    const size_t kstep = (size_t)(BK * 2);
    const size_t hstepA = (size_t)HALF * g.lda * 2, hstepB = (size_t)HALF * g.ldb * 2;
    const unsigned ldsw = (unsigned)wid * 1024u; const unsigned lds0 = (unsigned)(size_t)lds;
    const int aoff = lds_byte(wr * 64 + fr, fq * 8), boff = lds_byte(wc * 32 + fr, fq * 8);
#define PG8_SA(b, h) (((b) * 2 + (h)) * HTB)
#define PG8_SB(b, h) ((4 + (b) * 2 + (h)) * HTB)
#define PG8_STAGE(bufoff, gbase, voff) do { _Pragma("unroll") for (int _i = 0; _i < 2; ++_i) \
        glds16s((const void*)(gbase), (voff)[_i], (unsigned)__builtin_amdgcn_readfirstlane((int)(lds0 + (unsigned)(bufoff) + ldsw + (unsigned)_i * 8192u))); } while (0)
#define PG8_LDA(dst, b, h) do { _Pragma("unroll") for (int m = 0; m < 4; ++m) { dst[m].lo = *(const LAS bf16x8*)(lds + PG8_SA(b, h) + aoff + m * 2048); dst[m].hi = *(const LAS bf16x8*)(lds + PG8_SA(b, h) + aoff + m * 2048 + 1024); } } while (0)
#define PG8_LDB(dst, b, h) do { _Pragma("unroll") for (int n = 0; n < 2; ++n) { dst[n].lo = *(const LAS bf16x8*)(lds + PG8_SB(b, h) + boff + n * 2048); dst[n].hi = *(const LAS bf16x8*)(lds + PG8_SB(b, h) + boff + n * 2048 + 1024); } } while (0)
#define PG8_MMA(ai, bj, At, Bt) do { __builtin_amdgcn_s_setprio(1); _Pragma("unroll") for (int m = 0; m < 4; ++m) _Pragma("unroll") for (int n = 0; n < 2; ++n) { \
        if constexpr (FP8) asm volatile("v_mfma_scale_f32_16x16x128_f8f6f4 %0, %1, %2, %0, %3, %3 op_sel_hi:[0,0,0]" : "+v"(acc[ai][bj][m][n]) : "v"(__builtin_bit_cast(i32x8_t, Bt[n])), "v"(__builtin_bit_cast(i32x8_t, At[m])), "v"(0x7f7f7f7f));   \
        else { acc[ai][bj][m][n] = __builtin_amdgcn_mfma_f32_16x16x32_bf16(Bt[n].lo, At[m].lo, acc[ai][bj][m][n], 0, 0, 0); acc[ai][bj][m][n] = __builtin_amdgcn_mfma_f32_16x16x32_bf16(Bt[n].hi, At[m].hi, acc[ai][bj][m][n], 0, 0, 0); } } \
        __builtin_amdgcn_s_setprio(0); } while (0)
#define PG8_WAIT_V(n) asm volatile("s_waitcnt vmcnt(" #n ")" ::: "memory")
#define PG8_WAIT_L(n) asm volatile("s_waitcnt lgkmcnt(" #n ")" ::: "memory")
#define PG8_BAR __builtin_amdgcn_s_barrier()
#define PG8_SCHED __builtin_amdgcn_sched_barrier(0)
    Unit cur, nxt; int ui = 0;
    if (!S.next(0, cur)) return;
    f32x4 acc[2][2][4][2];
#pragma unroll
    for (int a = 0; a < 2; ++a)
#pragma unroll
        for (int b = 0; b < 2; ++b)
#pragma unroll
            for (int m = 0; m < 4; ++m)
#pragma unroll
                for (int n = 0; n < 2; ++n) acc[a][b][m][n] = (f32x4){0.f, 0.f, 0.f, 0.f};
    bf16x16_t At[4], B0[2], B1[2];
    const char* cA = cur.a; const char* cB = cur.b;
    S.a_ready(cur);
    PG8_STAGE(PG8_SB(0, 0), cB, voffB); PG8_STAGE(PG8_SB(0, 1), cB + hstepB, voffB); PG8_STAGE(PG8_SA(0, 0), cA, voffA); PG8_STAGE(PG8_SA(0, 1), cA + hstepA, voffA);
    if (wr == 1) PG8_BAR;
    PG8_WAIT_V(2); PG8_BAR;
    PG8_STAGE(PG8_SB(1, 0), cB + kstep, voffB); PG8_STAGE(PG8_SA(1, 0), cA + kstep, voffA); PG8_STAGE(PG8_SB(1, 1), cB + hstepB + kstep, voffB);
    PG8_WAIT_V(6); PG8_BAR;
    for (;;) {
        const bool has_next = S.next(ui + 1, nxt);
        const char* nA = has_next ? nxt.a : cA; const char* nB = has_next ? nxt.b : cB;
        for (int t = 0; t < nt; t += 2) {
            const bool last = (t == nt - 2);
            const char* a1 = cA + (size_t)(t + 1) * kstep;
            const char* a2 = last ? nA : cA + (size_t)(t + 2) * kstep; const char* b2 = last ? nB : cB + (size_t)(t + 2) * kstep;
            const char* a3 = a2 + kstep; const char* b3 = b2 + kstep;
            if (last && has_next) S.a_ready(nxt);
            PG8_LDB(B0, 0, 0); PG8_LDB(B1, 0, 1); PG8_SCHED; PG8_LDA(At, 0, 0); PG8_STAGE(PG8_SA(1, 1), a1 + hstepA, voffA);
            PG8_WAIT_V(8); PG8_WAIT_L(0); PG8_BAR; PG8_MMA(0, 0, At, B0); PG8_MMA(0, 1, At, B1); PG8_BAR; PG8_SCHED;
            PG8_LDA(At, 0, 1); PG8_STAGE(PG8_SB(0, 0), b2, voffB); PG8_STAGE(PG8_SB(0, 1), b2 + hstepB, voffB); PG8_STAGE(PG8_SA(0, 0), a2, voffA);
            PG8_WAIT_V(8); PG8_WAIT_L(0); PG8_BAR; PG8_MMA(1, 0, At, B0); PG8_MMA(1, 1, At, B1); PG8_BAR; PG8_SCHED;
            PG8_LDB(B0, 1, 0); PG8_LDB(B1, 1, 1); PG8_SCHED; PG8_LDA(At, 1, 0); PG8_STAGE(PG8_SA(0, 1), a2 + hstepA, voffA);
            PG8_WAIT_V(8); PG8_WAIT_L(0); PG8_BAR; PG8_MMA(0, 0, At, B0); PG8_MMA(0, 1, At, B1); PG8_BAR; PG8_SCHED;
            PG8_LDA(At, 1, 1); PG8_STAGE(PG8_SB(1, 0), b3, voffB); PG8_STAGE(PG8_SB(1, 1), b3 + hstepB, voffB); PG8_STAGE(PG8_SA(1, 0), a3, voffA);
            PG8_WAIT_V(8); PG8_WAIT_L(0); PG8_BAR; PG8_MMA(1, 0, At, B0); PG8_MMA(1, 1, At, B1); PG8_BAR; PG8_SCHED;
        }
        if constexpr (ALIGN_EPI) { if (wr == 0) PG8_BAR; }
        if constexpr (FP8) asm volatile("s_nop 15\n\ts_nop 15" ::: "memory");
        E(acc, cur, wr, wc, fr, fq); S.done(cur);
        if (!has_next) break;
#pragma unroll
        for (int a = 0; a < 2; ++a)
#pragma unroll
            for (int b = 0; b < 2; ++b)
#pragma unroll
                for (int m = 0; m < 4; ++m)
#pragma unroll
                    for (int n = 0; n < 2; ++n) acc[a][b][m][n] = (f32x4){0.f, 0.f, 0.f, 0.f};
        cur = nxt; cA = nA; cB = nB; ++ui;
        if constexpr (ALIGN_EPI) { if (wr == 1) PG8_BAR; }
    }
    PG8_WAIT_V(0);
    if constexpr (!ALIGN_EPI) { if (wr == 0) PG8_BAR; }
    PG8_BAR;
#undef PG8_SA
#undef PG8_SB
#undef PG8_STAGE
#undef PG8_LDA
#undef PG8_LDB
#undef PG8_MMA
#undef PG8_WAIT_V
#undef PG8_WAIT_L
#undef PG8_BAR
#undef PG8_SCHED
}
}

#define XB_TMO      128
#define XB_XCNT(j)  (256  + 64 * (j))
#define XB_XSUB(j)  (1280 + 64 * (j))
#define XB_XGEN(j)  (2304 + 64 * (j))
#define XB_TOP      3328
#define XB_TOPGEN   3392
#define XCD_BAR_WORDS 3456
#define XB_SPIN_CAP (1u << 18)
__device__ __forceinline__ unsigned xb_ld(unsigned* p)              { return __hip_atomic_load(p, __ATOMIC_RELAXED, __HIP_MEMORY_SCOPE_AGENT); }
__device__ __forceinline__ unsigned xb_add(unsigned* p, unsigned v) { return __hip_atomic_fetch_add(p, v, __ATOMIC_RELAXED, __HIP_MEMORY_SCOPE_AGENT); }
__device__ __forceinline__ unsigned xb_xcc_id() { return (unsigned)__builtin_amdgcn_s_getreg((3 << 11) | 20) & 0xFu; }
#define XB_SPIN(cond, bar) do { unsigned _sp = 0; while (cond) { __builtin_amdgcn_s_sleep(1); \
    if ((++_sp & 255u) == 0u) { if (xb_ld(&(bar)[XB_TMO])) break; if (_sp > XB_SPIN_CAP) { atomicAdd(&(bar)[XB_TMO], 1u); break; } } } } while (0)
struct XcdBarrier { unsigned* bar; unsigned x; volatile LAS unsigned* st; };
__device__ __forceinline__ XcdBarrier xcd_barrier_post(unsigned* bar, volatile LAS unsigned* st) {
    XcdBarrier b; b.bar = bar; b.x = xb_xcc_id(); b.st = st;
    if (threadIdx.x == 0) (void)xb_add(&bar[XB_XCNT(b.x)], 1u);
    return b;
}
__device__ __forceinline__ void xcd_barrier_complete(unsigned* bar, unsigned x, unsigned& nloc, unsigned& nx) {
    const unsigned G = gridDim.x * gridDim.y * gridDim.z;
    unsigned sum, cnt, mine, sp = 0u;
    for (;;) {
        sum = 0u; cnt = 0u; mine = 0u;
#pragma unroll
        for (unsigned j = 0; j < 16; ++j) { const unsigned c = xb_ld(&bar[XB_XCNT(j)]); sum += c; cnt += (c > 0u) ? 1u : 0u; mine = (j == x) ? c : mine; }
        if (sum == G) break;
        __builtin_amdgcn_s_sleep(1);
        if ((++sp & 255u) == 0u) { if (xb_ld(&bar[XB_TMO])) break; if (sp > XB_SPIN_CAP) { atomicAdd(&bar[XB_TMO], 1u); break; } }
    }
    nloc = mine > 0u ? mine : 1u; nx = cnt > 0u ? cnt : 1u;
}
__device__ __forceinline__ void xcd_barrier(const XcdBarrier& b) {
    asm volatile("s_waitcnt vmcnt(0)" ::: "memory");
    __syncthreads();
    if (threadIdx.x == 0) {
        unsigned* bar = b.bar;
        __builtin_amdgcn_s_waitcnt(0);
        unsigned nloc = b.st[0], nx = b.st[1];
        if (nloc == 0u) { xcd_barrier_complete(bar, b.x, nloc, nx); b.st[0] = nloc; b.st[1] = nx; }
        const unsigned old = xb_add(&bar[XB_XSUB(b.x)], 1u);
        const unsigned gen = old / nloc;
        if (old + 1u == (gen + 1u) * nloc) {
            __builtin_amdgcn_fence(__ATOMIC_RELEASE, "agent");
            asm volatile("s_waitcnt vmcnt(0)" ::: "memory");
            const unsigned og = xb_add(&bar[XB_TOP], 1u);
            const unsigned tg = og / nx;
            if (og + 1u == (tg + 1u) * nx) xb_add(&bar[XB_TOPGEN], 1u);
            else XB_SPIN(xb_ld(&bar[XB_TOPGEN]) == tg, bar);
            __builtin_amdgcn_fence(__ATOMIC_ACQUIRE, "agent");
            xb_add(&bar[XB_XGEN(b.x)], 1u);
            asm volatile("s_waitcnt vmcnt(0)" ::: "memory");
        } else {
            XB_SPIN(xb_ld(&bar[XB_XGEN(b.x)]) == gen, bar);
            __builtin_amdgcn_fence(__ATOMIC_ACQUIRE, "agent");
            asm volatile("s_waitcnt vmcnt(0)" ::: "memory");
        }
    }
    __syncthreads();
}

struct Args { const float* in[28]; float* out; unsigned char* ws; int ph_lo, ph_hi, dup, pad; };
enum { I_X = 0, I_MEM, I_NMIXG, I_WIN, I_SGUNG, I_SGUW, I_SGUB, I_QNG, I_KNG, I_LQ1, I_LK1, I_LQ2, I_LK2, I_SUBG, I_RELB, I_WOUT, I_NCG, I_NMG, I_WCQ, I_WCKV, I_CQG, I_CKG, I_WCO, I_NFG, I_PWQ, I_PKEYS, I_PU, I_PV };
constexpr int NPHASE = 11;

template <bool GAIN, bool OUT8 = false> __device__ __forceinline__ void p0_transpose_item(const float* W, int K, int N, bf16_t* WT, LAS float* scr, int item, int lane, const float* gk = nullptr) {
    const int nblk = N / 32, kb = item / nblk, nb = item % nblk, k0 = 64 * kb, n0 = 32 * nb;
#pragma unroll 16
    for (int i = 0; i < 32; ++i) { const int kk = 2 * i + (lane >> 5); scr[kk * 33 + (lane & 31)] = W[(size_t)(k0 + kk) * N + n0 + (lane & 31)]; }
    const int c = lane & 7;
    f32x4 g0 = (f32x4){1.f, 1.f, 1.f, 1.f}, g1 = g0;
    if (GAIN) { g0 = *(const f32x4*)(gk + k0 + 8 * c); g1 = *(const f32x4*)(gk + k0 + 8 * c + 4); }
    asm volatile("s_waitcnt lgkmcnt(0)" ::: "memory");
#pragma unroll
    for (int j = 0; j < 4; ++j) { const int n = (lane >> 3) + 8 * j; const LAS float* s = scr + (8 * c) * 33 + n;
        u32x4 o; o.x = pk2(s[0 * 33] * g0[0], s[1 * 33] * g0[1]); o.y = pk2(s[2 * 33] * g0[2], s[3 * 33] * g0[3]); o.z = pk2(s[4 * 33] * g1[0], s[5 * 33] * g1[1]); o.w = pk2(s[6 * 33] * g1[2], s[7 * 33] * g1[3]);
        if (OUT8) *(u32x2*)((unsigned char*)WT + (size_t)(n0 + n) * K + k0 + 8 * c) = pack8_fp8((f32x4){s[0 * 33] * g0[0], s[1 * 33] * g0[1], s[2 * 33] * g0[2], s[3 * 33] * g0[3]} * W8_SCALE, (f32x4){s[4 * 33] * g1[0], s[5 * 33] * g1[1], s[6 * 33] * g1[2], s[7 * 33] * g1[3]} * W8_SCALE);
        else *(u32x4*)(WT + (size_t)(n0 + n) * K + k0 + 8 * c) = o; }
    asm volatile("s_waitcnt lgkmcnt(0)" ::: "memory");
}
__device__ __forceinline__ void rms_row_to_bf16(const float* xrow, const float* g, bf16_t* orow, int lane, unsigned char* o8row = nullptr) {
    const f32x4* xr = (const f32x4*)xrow + lane; const f32x4* gr = (const f32x4*)g + lane;
    f32x4 v[8]; float s = 0.f;
#pragma unroll
    for (int j = 0; j < 8; ++j) { v[j] = xr[64 * j]; s += (v[j][0] * v[j][0] + v[j][1] * v[j][1]) + (v[j][2] * v[j][2] + v[j][3] * v[j][3]); }
    const float rstd = 1.0f / sqrtf(wave_sum(s) * (1.0f / 2048.0f) + EPS);
    u32x2* o8 = (u32x2*)orow + lane;
#pragma unroll
    for (int j = 0; j < 8; ++j) { const f32x4 gg = gr[64 * j]; const f32x4 y = (f32x4){v[j][0] * rstd * gg[0], v[j][1] * rstd * gg[1], v[j][2] * rstd * gg[2], v[j][3] * rstd * gg[3]};
        u32x2 w; w.x = pk2(y[0], y[1]); w.y = pk2(y[2], y[3]); o8[64 * j] = w;
        if (o8row) { f32x4 z = y * A8_SCALE;
#pragma unroll
            for (int i = 0; i < 4; ++i) z[i] = __builtin_amdgcn_fmed3f(z[i], -448.0f, 448.0f);
            int b = __builtin_amdgcn_cvt_pk_fp8_f32(z[0], z[1], 0, false); b = __builtin_amdgcn_cvt_pk_fp8_f32(z[2], z[3], b, true);
            ((unsigned*)o8row)[64 * j + lane] = (unsigned)b; } }
}
__device__ __forceinline__ void cvt_chunk(const float* src, bf16_t* dst, size_t chunk, int lane) {
    const f32x4* s = (const f32x4*)(src + chunk * 512) + lane * 2; const f32x4 a = s[0], b = s[1];
    u32x4 w; w.x = pk2(a[0], a[1]); w.y = pk2(a[2], a[3]); w.z = pk2(b[0], b[1]); w.w = pk2(b[2], b[3]);
    *((u32x4*)(dst + chunk * 512) + lane) = w;
}

__device__ __forceinline__ void row_to_fp8(const float* src, unsigned char* T8, float* scl, int e, int lane, const float* gc = nullptr) {
    const f32x4* s0 = (const f32x4*)(src + (size_t)e * 2048 + 16 * lane); const f32x4* s1 = s0 + 256;
    f32x4 v[8]; float m = 0.f;
#pragma unroll
    for (int i = 0; i < 4; ++i) { v[i] = s0[i]; v[4 + i] = s1[i]; }
    if (gc) { const f32x4* g0 = (const f32x4*)(gc + 16 * lane);
#pragma unroll
        for (int i = 0; i < 4; ++i) { v[i] = v[i] * g0[i]; v[4 + i] = v[4 + i] * g0[256 + i]; } }
#pragma unroll
    for (int i = 0; i < 8; ++i) m = fmaxf(fmaxf(m, fmaxf(fabsf(v[i][0]), fabsf(v[i][1]))), fmaxf(fabsf(v[i][2]), fabsf(v[i][3])));
    m = wave_max(m); const float sc = m > 0.f ? 448.0f / m : 1.0f;
#pragma unroll
    for (int hf = 0; hf < 2; ++hf) { u32x4 w;
#pragma unroll
        for (int i = 0; i < 4; ++i) { const f32x4 x = v[hf * 4 + i] * sc; int t = __builtin_amdgcn_cvt_pk_fp8_f32(x[0], x[1], 0, false); t = __builtin_amdgcn_cvt_pk_fp8_f32(x[2], x[3], t, true); w[i] = (unsigned)t; }
        *(u32x4*)(T8 + (size_t)(hf * 8 + (lane >> 3)) * ((size_t)16384 * 128) + (size_t)e * 128 + (lane & 7) * 16) = w; }
    if (lane == 0) scl[e] = m > 0.f ? m * (1.0f / 448.0f) : 1.0f;
}
__device__ __forceinline__ void row_fp4_load(const float* src, int e, int lane, f32x4 (&v)[8]) {
    const f32x4* s0 = (const f32x4*)(src + (size_t)e * 2048) + lane;
#pragma unroll
    for (int i = 0; i < 8; ++i) v[i] = __builtin_nontemporal_load(s0 + 64 * i);
}
__device__ __forceinline__ void row_fp4_store(f32x4 (&v)[8], unsigned char* T4, float* scl, int e, int lane, const float* gc = nullptr) {
    float m = 0.f;
    if (gc) { const f32x4* g0 = (const f32x4*)gc + lane;
#pragma unroll
        for (int i = 0; i < 8; ++i) v[i] = v[i] * g0[64 * i]; }
#pragma unroll
    for (int i = 0; i < 8; ++i) m = fmaxf(fmaxf(m, fmaxf(fabsf(v[i][0]), fabsf(v[i][1]))), fmaxf(fabsf(v[i][2]), fabsf(v[i][3])));
    m = wave_max(m); const float sc = m > 0.f ? 6.0f / m : 1.0f;
#pragma unroll
    for (int i = 0; i < 8; ++i) { unsigned acc = 0u;
        const f32x4 x0 = v[i] * sc;
        acc = __builtin_amdgcn_cvt_scalef32_pk_fp4_f32(acc, x0[0], x0[1], 1.0f, 0); acc = __builtin_amdgcn_cvt_scalef32_pk_fp4_f32(acc, x0[2], x0[3], 1.0f, 1);
        *(unsigned short*)(T4 + (size_t)i * ((size_t)16384 * 128) + (size_t)e * 128 + lane * 2) = (unsigned short)acc; }
    if (lane == 0) scl[e] = m > 0.f ? m * (1.0f / 6.0f) : 1.0f;
}
__device__ __forceinline__ bf16x8 fp4x8_bf16(unsigned d) {
    typedef __bf16 bf16x2_t __attribute__((ext_vector_type(2)));
    u32x4 w; w.x = __builtin_bit_cast(unsigned, __builtin_amdgcn_cvt_scalef32_pk_bf16_fp4(d, 1.0f, 0)); w.y = __builtin_bit_cast(unsigned, __builtin_amdgcn_cvt_scalef32_pk_bf16_fp4(d, 1.0f, 1));
    w.z = __builtin_bit_cast(unsigned, __builtin_amdgcn_cvt_scalef32_pk_bf16_fp4(d, 1.0f, 2)); w.w = __builtin_bit_cast(unsigned, __builtin_amdgcn_cvt_scalef32_pk_bf16_fp4(d, 1.0f, 3));
    return __builtin_bit_cast(bf16x8, w);
}
__device__ __forceinline__ bf16x8 fp8x8_bf16(unsigned d0, unsigned d1) {
    const f32x2 a = __builtin_amdgcn_cvt_pk_f32_fp8((int)d0, false), b = __builtin_amdgcn_cvt_pk_f32_fp8((int)d0, true), c = __builtin_amdgcn_cvt_pk_f32_fp8((int)d1, false), d = __builtin_amdgcn_cvt_pk_f32_fp8((int)d1, true);
    u32x4 w; w.x = cvt_pk_bf16(a.x, a.y); w.y = cvt_pk_bf16(b.x, b.y); w.z = cvt_pk_bf16(c.x, c.y); w.w = cvt_pk_bf16(d.x, d.y);
    return __builtin_bit_cast(bf16x8, w);
}

__device__ __forceinline__ int t5_bucket(int n) {
    if (n < 16) return n;
    int b = 16;
    b += (n >= 19); b += (n >= 21); b += (n >= 24); b += (n >= 27); b += (n >= 31); b += (n >= 35); b += (n >= 40); b += (n >= 46);
    b += (n >= 52); b += (n >= 59); b += (n >= 67); b += (n >= 77); b += (n >= 87); b += (n >= 99); b += (n >= 113);
    return b;
}

__device__ __forceinline__ int fresh_lane() { unsigned l; asm volatile("v_mbcnt_lo_u32_b32 %0, -1, 0\n\tv_mbcnt_hi_u32_b32 %0, -1, %0" : "=v"(l)); return (int)l; }
__device__ __forceinline__ void glds16(const void* gsrc, unsigned lds_dst) { unsigned keep;
    asm volatile("s_mov_b32 %0, m0\n\ts_mov_b32 m0, %2\n\ts_nop 0\n\tglobal_load_lds_dwordx4 %1, off\n\ts_mov_b32 m0, %0" : "=&s"(keep) : "v"(gsrc), "s"(lds_dst) : "memory"); }
__device__ __forceinline__ int f2s(float f) { int s = __builtin_bit_cast(int, f); return s ^ ((s >> 31) & 0x7fffffff); }
__device__ __forceinline__ float s2f(int s) { return __builtin_bit_cast(float, s ^ ((s >> 31) & 0x7fffffff)); }
#define INS16(L, vv) do { int _v = (vv); _Pragma("unroll") for (int _j = 0; _j < 16; ++_j) { const int _h = max(L[_j], _v); _v = min(L[_j], _v); L[_j] = _h; } } while (0)

#define CEX(L, i_, j_) do { const int _a = max(L[i_], L[j_]), _b = min(L[i_], L[j_]); L[i_] = _a; L[j_] = _b; } while (0)
__device__ __forceinline__ void bitonic_sort16(int (&L)[16]) {
#pragma unroll
    for (int k = 2; k <= 16; k <<= 1)
#pragma unroll
        for (int j = k >> 1; j >= 1; j >>= 1)
#pragma unroll
            for (int i = 0; i < 16; ++i) { const int l = i ^ j; if (l > i) { if ((i & k) == 0) CEX(L, i, l); else CEX(L, l, i); } }
}
__device__ __forceinline__ void merge_top16(int (&L)[16], const int (&N)[16]) {
#pragma unroll
    for (int i = 0; i < 16; ++i) L[i] = max(L[i], N[15 - i]);
#pragma unroll
    for (int d = 8; d >= 1; d >>= 1)
#pragma unroll
        for (int i = 0; i < 16; ++i) if ((i & d) == 0) CEX(L, i, i + d);
}
__device__ __forceinline__ void peer_top16(const bf16_t* qp, const bf16_t* kp, int hh, int (&L)[16]) {
#pragma unroll
    for (int i = 0; i < 16; ++i) L[i] = (int)0x80000000;
#pragma unroll 1
    for (int kt = 0; kt < 4; ++kt) {
        f32x16 sc = (f32x16){};
#pragma unroll
        for (int k0 = 0; k0 < 8; ++k0) { const bf16x8 af = *(const bf16x8*)(kp + (size_t)kt * 32 * 128 + 16 * k0); const bf16x8 bq = *(const bf16x8*)(qp + 16 * k0); sc = __builtin_amdgcn_mfma_f32_32x32x16_bf16(af, bq, sc, 0, 0, 0); }
        const int kbase = 32 * kt + 4 * hh;
        int N[16];
#pragma unroll
        for (int r = 0; r < 16; ++r) N[r] = (f2s(sc[r]) & ~0x7f) | (kbase + (r & 3) + 8 * (r >> 2));
        bitonic_sort16(N);
        merge_top16(L, N);
    }
    int m[16];
#pragma unroll
    for (int i = 0; i < 16; ++i) { auto rr = __builtin_amdgcn_permlane32_swap((unsigned)L[i], (unsigned)L[i], false, false); m[i] = hh ? (int)rr[0] : (int)rr[1]; }
    merge_top16(L, m);
}

template <int VAR3, int VAR10 = 0> __global__ void __launch_bounds__(512, 2) fwd_t(Args args) {
    extern __shared__ __attribute__((aligned(16))) unsigned char lds_raw[];
    LAS unsigned char* lds = (LAS unsigned char*)lds_raw;
    volatile LAS unsigned* MISC = (volatile LAS unsigned*)(lds + MISC_OFF);
    const int tid = threadIdx.x, lane = tid & 63, wave = __builtin_amdgcn_readfirstlane(tid >> 6);
    const int G = gridDim.x, bx = blockIdx.x, vcu = (G % 8 == 0) ? (bx % 8) * (G / 8) + bx / 8 : bx;
    unsigned char* ws = args.ws;
    unsigned* ctl = (unsigned*)(ws + WS_CTL);
    for (int u = tid; u < (LDS_BYTES - RING_BYTES) / 4; u += 512) ((LAS unsigned*)(lds + RING_BYTES))[u] = 0u;
    __syncthreads();
#if MK_SPLIT
#define GRID_BAR() do { } while (0)
#else
    XcdBarrier bar = xcd_barrier_post(ctl + CW_BAR, MISC + 8);
#define GRID_BAR() xcd_barrier(bar)
#endif
    const int lo = args.ph_lo, hi = args.ph_hi;
#ifdef ONLY_PHASE
#define IN(k) ((k) == ONLY_PHASE)
#else
#define IN(k) ((VAR10 == 0 || (k) == 10) && (VAR3 == 0 || (k) == 3) && lo <= (k) && (k) < hi)
#endif
#define SEAM(k) do { if (IN(k) && IN((k) + 1)) GRID_BAR(); } while (0)

    bf16_t* WIN = (bf16_t*)(ws + WS_WIN); bf16_t* WOUT = (bf16_t*)(ws + WS_WOUT); bf16_t* WCQ = (bf16_t*)(ws + WS_WCQ); bf16_t* WCKV = (bf16_t*)(ws + WS_WCKV);
    bf16_t* WCO = (bf16_t*)(ws + WS_WCO); bf16_t* WPQ = (bf16_t*)(ws + WS_WPQ); bf16_t* KEYS = (bf16_t*)(ws + WS_KEYS); bf16_t* SGUW = (bf16_t*)(ws + WS_SGUW);
    float* KGQG = (float*)(ws + WS_MISC);
    bf16_t* MEMN = (bf16_t*)(ws + WS_MEMN); bf16_t* KC = (bf16_t*)(ws + WS_KC); bf16_t* VCT = (bf16_t*)(ws + WS_VCT); float* LPART = (float*)(ws + WS_LPART);
    bf16_t* XN = (bf16_t*)(ws + WS_XN); bf16_t* Z = (bf16_t*)(ws + WS_Z); bf16_t* QC = (bf16_t*)(ws + WS_QC); bf16_t* PC = (bf16_t*)(ws + WS_PC); bf16_t* QP = (bf16_t*)(ws + WS_QP);
    bf16_t* VT = (bf16_t*)(ws + WS_VT); bf16_t* MIX = (bf16_t*)(ws + WS_MIX);
    u64* SSQ1 = (u64*)(ws + CB_SSQ1); u64* SSQ2 = (u64*)(ws + CB_SSQ2); u64* SSQK = (u64*)(ws + CB_SSQK); u64* SSQQ = (u64*)(ws + CB_SSQQ);
#if MK_SPLIT
    const bool dup = args.dup != 0;
    u64* SSQ1w = dup ? (u64*)(ws + WS_MISC + 65536) : SSQ1; u64* SSQ2w = dup ? (u64*)(ws + WS_MISC + 65536) : SSQ2; u64* SSQKw = dup ? (u64*)(ws + WS_MISC + 65536) : SSQK; u64* SSQQw = dup ? (u64*)(ws + WS_MISC + 65536) : SSQQ;
    const float dupscale = dup ? 0.f : 1.f; bf16_t* QKNW = dup ? XN : Z + 2048; const int qknld = dup ? 2048 : 4096;
#else
    u64* SSQ1w = SSQ1; u64* SSQ2w = SSQ2; u64* SSQKw = SSQK; u64* SSQQw = SSQQ; const float dupscale = 1.f; bf16_t* QKNW = Z + 2048; const int qknld = 4096;
#endif
#define P10SCALE ((VAR10 != 0) ? 0.0f : 1.0f)
#define P10STORE (VAR10 == 0)
    const int gw = vcu * 8 + wave, NGW = G * 8;

    if (IN(0)) {
        LAS float* scr = (LAS float*)(lds + wave * 16384);
        constexpr int I_IN = 32 * (5120 / 32), I_SQ = 32 * (2048 / 32), I_KV = 32 * (4096 / 32);
        constexpr int NIT = I_IN + 4 * I_SQ + I_KV;
        for (int it = gw; it < NIT; it += NGW) {
            int r = it;
            if (r < I_IN) { if (r % (5120 / 32) < 2048 / 32) p0_transpose_item<false, true>(args.in[I_WIN], 2048, 5120, WIN, scr, r, lane);
                            else p0_transpose_item<false>(args.in[I_WIN], 2048, 5120, WIN, scr, r, lane); continue; } r -= I_IN;
            if (r < I_SQ) { p0_transpose_item<false>(args.in[I_WOUT], 2048, 2048, WOUT, scr, r, lane); continue; } r -= I_SQ;
            if (r < I_SQ) { p0_transpose_item<true, true>(args.in[I_WCQ], 2048, 2048, WCQ, scr, r, lane, args.in[I_NCG]); continue; } r -= I_SQ;
            if (r < I_KV) { p0_transpose_item<false>(args.in[I_WCKV], 2048, 4096, WCKV, scr, r, lane); continue; } r -= I_KV;
            if (r < I_SQ) { p0_transpose_item<false, true>(args.in[I_WCO], 2048, 2048, WCO, scr, r, lane); continue; } r -= I_SQ;
            p0_transpose_item<true>(args.in[I_PWQ], 2048, 2048, WPQ, scr, r, lane, args.in[I_NFG]);
        }
        for (int m = gw; m < T; m += NGW) rms_row_to_bf16(args.in[I_X] + (size_t)m * D, args.in[I_NMIXG], XN + (size_t)m * D, lane, ws + WS_MIX + (size_t)m * D);
        for (int m = gw; m < MROWS; m += NGW) rms_row_to_bf16(args.in[I_MEM] + (size_t)m * D, args.in[I_NMG], MEMN + (size_t)m * D, lane);
        for (int c = gw; c < 262144 / 512; c += NGW) cvt_chunk(args.in[I_PKEYS], KEYS, c, lane);
        { f32x4 ua[8], va[8];
          if (gw < 16384) { row_fp4_load(args.in[I_PU], gw, lane, ua); row_fp4_load(args.in[I_PV], gw, lane, va); }
          for (int e = gw; e < 16384; e += NGW) { f32x4 ub[8], vb[8]; const int en = (e + NGW < 16384) ? e + NGW : e;
              row_fp4_load(args.in[I_PU], en, lane, ub); row_fp4_load(args.in[I_PV], en, lane, vb);
              row_fp4_store(ua, ws + WS_U8, (float*)(ws + WS_USC), e, lane, args.in[I_NFG]); row_fp4_store(va, ws + WS_V8, (float*)(ws + WS_VSC), e, lane);
#pragma unroll
              for (int i = 0; i < 8; ++i) { ua[i] = ub[i]; va[i] = vb[i]; } } }
        for (int i = gw * 64 + lane; i < 8 * 128 * 128; i += NGW * 64) { const int p = (i >> 7) & 127, q = i & 127; SGUW[i] = (bf16_t)f2bf(q <= p ? args.in[I_SGUW][i] : 0.f); }
        if (bx == 0) { const float v = args.in[I_CKG][tid] * args.in[I_CQG][tid]; KGQG[tid] = v; }
    }
    SEAM(0);

    if (IN(1)) {
        { pg8::Gemm g{D / 2, D / 2, D / 2}; pg8::PlainOrder S; S.init(ws + WS_MIX, WIN, D / 2, D / 2, T, 2048, G, bx);
          pg8::EpiB<true, false, false, false> E{Z, 4096, 8, nullptr, 0, nullptr, 0.f, nullptr, 0, 1, 1.0f / (A8_SCALE * W8_SCALE)};
          pg8::gemm_phase<true>(lds, g, S, E); }
        { pg8::Gemm g{D, D, D}; pg8::PlainOrder S; S.init(XN, WIN + (size_t)2048 * D, D, D, T, 2048, G, bx);
          pg8::EpiB<false, false, false, false> E{Z + 2048, 4096, 0, nullptr, 0, nullptr, 0.f, nullptr, 0, 1};
          pg8::gemm_phase(lds, g, S, E); }
        { pg8::Gemm g{D, D, D}; pg8::PlainOrder S; S.init(WIN + (size_t)4096 * D, XN, D, D, 1024, T, G, bx);
          pg8::EpiB<false, false, false, false> E{VT, T, 0, nullptr, 0, nullptr, 0.f, nullptr, 0, 1};
          pg8::gemm_phase(lds, g, S, E); }
    }
    SEAM(1);

    if (IN(2)) {
        constexpr int VROW = 136;
        LAS bf16_t* vnT = (LAS bf16_t*)lds;
        const float* sgu_g = args.in[I_SGUNG]; const float* sgu_b = args.in[I_SGUB];
        const bool kvsplit = (G == 256); const bool kvcu = kvsplit && vcu < 64;
        const int sv = kvsplit ? vcu - 64 : vcu, SG = kvsplit ? G - 64 : G;
        if (kvcu || !kvsplit) { pg8::Gemm g{D, D, D};
          pg8::PairOrder S{(const char*)MEMN, (const char*)WCKV, (const char*)(WCKV + (size_t)2048 * D), (const char*)MEMN, D, D, MROWS / 256, 2048 / 256, 2048 / 256, MROWS / 256, kvsplit ? 64 : G, vcu};
          pg8::EpiKV E{KC, VCT, KGQG, SSQKw};
          pg8::gemm_phase(lds, g, S, E); }
        if (!kvcu)
        for (int uidx = sv; uidx < 1024; uidx += SG) {
            const int b = uidx >> 8, n = (uidx >> 3) & 31, h = uidx & 7; const size_t t0 = (size_t)b * SEQ + n * 128;
            __syncthreads();
            { const int p = tid >> 2, part = tid & 3; const bf16_t* vp = Z + (t0 + p) * 4096 + 1024 + h * 128 + part * 32;
              u32x4 raw[4]; float f[32]; float s = 0.f;
#pragma unroll
              for (int i = 0; i < 4; ++i) raw[i] = *(const u32x4*)(vp + i * 8);
#pragma unroll
              for (int i = 0; i < 4; ++i)
#pragma unroll
                  for (int e = 0; e < 4; ++e) { f[i * 8 + 2 * e] = bflo(raw[i][e]); f[i * 8 + 2 * e + 1] = bfhi(raw[i][e]); }
#pragma unroll
              for (int i = 0; i < 32; ++i) s += f[i] * f[i];
              s += __shfl_xor(s, 1); s += __shfl_xor(s, 2);
              const float rstd = 1.0f / sqrtf(s * (1.0f / 128.0f) + EPS);
#pragma unroll
              for (int i = 0; i < 32; ++i) { const int c = part * 32 + i; vnT[c * VROW + p] = (bf16_t)f2bf(f[i] * rstd * sgu_g[h * 128 + c]); }
            }
            __syncthreads();
            { const int wp = wave & 3, wcc = wave >> 2, j = lane & 31, hh = lane >> 5;
              f32x16 acc[2]; acc[0] = (f32x16){}; acc[1] = (f32x16){};
              const bf16_t* wrow = SGUW + ((size_t)h * 128 + 32 * wp + j) * 128 + 8 * hh;
              for (int ks = 0; ks <= 2 * wp + 1; ++ks) {
                  const bf16x8 bfr = *(const bf16x8*)(wrow + 16 * ks);
#pragma unroll
                  for (int ct = 0; ct < 2; ++ct) { const bf16x8 afr = *(const LAS bf16x8*)(vnT + (64 * wcc + 32 * ct + j) * VROW + 16 * ks + 8 * hh);
                      acc[ct] = __builtin_amdgcn_mfma_f32_32x32x16_bf16(afr, bfr, acc[ct], 0, 0, 0); }
              }
              const int p = 32 * wp + j; const float bs = sgu_b[h * 128 + p]; const size_t tok = t0 + p;
#pragma unroll
              for (int ct = 0; ct < 2; ++ct)
#pragma unroll
                  for (int g4 = 0; g4 < 4; ++g4) { const int c = 64 * wcc + 32 * ct + 8 * g4 + 4 * hh;
                      const u32x2 uu = *(const u32x2*)(Z + tok * 4096 + h * 128 + c);
                      const float o0 = bflo(uu.x) * (acc[ct][4 * g4 + 0] + bs), o1 = bfhi(uu.x) * (acc[ct][4 * g4 + 1] + bs), o2 = bflo(uu.y) * (acc[ct][4 * g4 + 2] + bs), o3 = bfhi(uu.y) * (acc[ct][4 * g4 + 3] + bs);
                      u32x2 w; w.x = pk2(o0, o1); w.y = pk2(o2, o3); *(u32x2*)(MIX + tok * D + h * 128 + c) = w; }
            }
        }
        { const float* qg = args.in[I_QNG]; const float* kg = args.in[I_KNG]; const int d0 = (lane & 7) * 8;
          float gq[8], gk[8];
#pragma unroll
          for (int e = 0; e < 8; ++e) { gq[e] = qg[d0 + e] * (0.125f * LOG2E); gk[e] = kg[d0 + e]; }
          if (!kvcu)
          for (int t = sv * 8 + wave; t < T; t += SG * 8) {
#pragma unroll
              for (int i = 0; i < 4; ++i) { const int vi = 8 * i + (lane >> 3); bf16_t* p = Z + (size_t)t * 4096 + 2048 + vi * 64 + d0;
                  const u32x4 raw = *(const u32x4*)p; float f[8];
#pragma unroll
                  for (int e = 0; e < 4; ++e) { f[2 * e] = bflo(raw[e]); f[2 * e + 1] = bfhi(raw[e]); }
                  float s = 0.f;
#pragma unroll
                  for (int e = 0; e < 8; ++e) s += f[e] * f[e];
                  s += __shfl_xor(s, 1); s += __shfl_xor(s, 2); s += __shfl_xor(s, 4);
                  const float rstd = 1.0f / sqrtf(s * (1.0f / 64.0f) + EPS);
                  u32x4 w;
#pragma unroll
                  for (int e = 0; e < 4; ++e) { const float g0 = (i < 2) ? gq[2 * e] : gk[2 * e], g1 = (i < 2) ? gq[2 * e + 1] : gk[2 * e + 1]; w[e] = pk2(f[2 * e] * rstd * g0, f[2 * e + 1] * rstd * g1); }
                  *(u32x4*)(QKNW + (size_t)t * qknld + vi * 64 + d0) = w; }
          }
        }
    }
    SEAM(2);

    if (IN(3)) {
        constexpr int STG = 32768;
        constexpr int var3 = VAR3; bf16_t* AOUT = (VAR3 != 0) ? XN : MIX;
        LAS float* tab = (LAS float*)(lds + RING_BYTES + 1024);
        const float* relb = args.in[I_RELB];
        const int j = lane & 31, hh = lane >> 5, w = wave, g = w & 3, c = w >> 2;
        const int pi = (j & ~12) | ((j & 4) << 1) | ((j & 8) >> 1);
        int koff[4], voff[4];
#pragma unroll
        for (int d0 = 0; d0 < 4; ++d0) { koff[d0] = c * 8192 + pi * 128 + (((2 * d0 + hh) ^ ((pi >> 1) & 7)) << 4); voff[d0] = 16384 + j * 128 + (((2 * d0 + hh) ^ ((j >> 1) & 7)) << 4); }
        const int bh = vcu >> 3, sidx = vcu & 7, b = bh >> 3, h = bh & 7;
        const unsigned lds0 = (unsigned)(size_t)lds;
        if (bh < 32) {
        __syncthreads();
        if (tid < 128) tab[tid] = relb[t5_bucket(tid) * 8 + h] * LOG2E;
        if (wave == 2) {
            const float a1 = wave_sum(args.in[I_LQ1][lane] * args.in[I_LK1][lane]), a2 = wave_sum(args.in[I_LQ2][lane] * args.in[I_LK2][lane]);
            const float gqm = wave_max(fabsf(args.in[I_QNG][lane])), gkm = wave_max(fabsf(args.in[I_KNG][lane]));
            const float bmax = wave_max(lane < 32 ? relb[lane * 8 + h] : -1e30f);
            const float M2 = LOG2E * (8.0f * gqm * gkm + bmax);
            if (lane == 0) { tab[128] = -M2; tab[129] = relb[31 * 8 + h] * LOG2E - M2; tab[130] = expf(a1) - expf(a2) + 0.2f; }
        }
        __syncthreads();
        const float c_near = tab[128], c_far = tab[129], lam = tab[130];
        const size_t tokbase = (size_t)b * SEQ;
        for (int ui = 0; ui < 4; ++ui) {
            const int qb = ui == 0 ? 31 - sidx : (ui == 1 ? 16 + sidx : (ui == 2 ? 15 - sidx : sidx));
            const int q0 = qb * 128, NT = (q0 + 128) / 64, my_last = qb * 2 + (g >> 1);
            const int qpos = q0 + 32 * g + j;
            bf16x8 Q[4];
            { const bf16_t* qrow = Z + (tokbase + qpos) * 4096 + 2048 + h * 128 + c * 64 + hh * 8;
#pragma unroll
              for (int d0 = 0; d0 < 4; ++d0) Q[d0] = *(const bf16x8*)(qrow + d0 * 16); }
            const int krow = 8 * w + (lane >> 3), kgr = (lane & 7) ^ ((krow >> 1) & 7);
            const int vd0 = 16 * w + (lane >> 3), vd1 = vd0 + 8;
            const unsigned kvo = (unsigned)(krow * 4096 + kgr * 8) * 2u;
            const unsigned vvo0 = (unsigned)(vd0 * T + ((lane & 7) ^ ((vd0 >> 1) & 7)) * 8) * 2u, vvo1 = (unsigned)(vd1 * T + ((lane & 7) ^ ((vd1 >> 1) & 7)) * 8) * 2u;
            const bf16_t* const kb0 = Z + tokbase * 4096 + 3072 + h * 128; const bf16_t* const vb0 = VT + (size_t)(h * 128) * T + tokbase;
#define DA_ISSUE(t_, st_) do { const bf16_t* kb_ = kb0 + (size_t)(t_) * 64 * 4096; const bf16_t* vb_ = vb0 + (t_) * 64; \
            const unsigned sb_ = (unsigned)__builtin_amdgcn_readfirstlane((int)(lds0 + (unsigned)(st_) * STG + (unsigned)w * 1024u)); \
            const unsigned sv_ = (unsigned)__builtin_amdgcn_readfirstlane((int)(lds0 + (unsigned)(st_) * STG + 16384u + (unsigned)w * 2048u)); \
            glds16s((const void*)kb_, kvo, sb_); glds16s((const void*)(kb_ + 64), kvo, sb_ + 8192u); \
            glds16s((const void*)vb_, vvo0, sv_); glds16s((const void*)vb_, vvo1, sv_ + 1024u); } while (0)
            f32x16 O[4];
#pragma unroll
            for (int dt = 0; dt < 4; ++dt) O[dt] = (f32x16){};
            float lsum = 0.f;
            bf16x8 P[4];
#pragma unroll
            for (int i = 0; i < 4; ++i) P[i] = (bf16x8){0, 0, 0, 0, 0, 0, 0, 0};
#define DA_LDK(kb_) do { _Pragma("unroll") for (int d0 = 0; d0 < 4; ++d0) { kf[2 * d0] = *(const LAS bf16x8*)((kb_) + koff[d0]); kf[2 * d0 + 1] = *(const LAS bf16x8*)((kb_) + 4096 + koff[d0]); } } while (0)
#define DA_LDVG(BUF, kb_, ks_) do { _Pragma("unroll") for (int dt = 0; dt < 4; ++dt) BUF[dt] = *(const LAS bf16x8*)((kb_) + dt * 4096 + voff[ks_]); } while (0)
#define DA_S(ci_) do { _Pragma("unroll") for (int r = 0; r < 16; ++r) S0[r] = (ci_); \
                S1 = __builtin_amdgcn_mfma_f32_32x32x16_bf16(kf[1], Q[0], S0, 0, 0, 0); S0 = __builtin_amdgcn_mfma_f32_32x32x16_bf16(kf[0], Q[0], S0, 0, 0, 0);     \
                _Pragma("unroll") for (int d0 = 1; d0 < 4; ++d0) { S0 = __builtin_amdgcn_mfma_f32_32x32x16_bf16(kf[2 * d0], Q[d0], S0, 0, 0, 0); S1 = __builtin_amdgcn_mfma_f32_32x32x16_bf16(kf[2 * d0 + 1], Q[d0], S1, 0, 0, 0); } } while (0)
#define DA_BIAS(key0_) do { _Pragma("unroll") for (int r = 0; r < 16; ++r) { const int kk = (key0_) + 16 * (r >> 3) + 8 * hh + (r & 7); const int d_0 = qpos - kk, d_1 = d_0 - 32; \
                    S0[r] = d_0 < 0 ? -INFINITY : S0[r] + tab[d_0 > 127 ? 127 : (d_0 < 0 ? 0 : d_0)]; \
                    S1[r] = d_1 < 0 ? -INFINITY : S1[r] + tab[d_1 > 127 ? 127 : (d_1 < 0 ? 0 : d_1)]; } } while (0)
#define DA_SX(n_) (((n_) < 16) ? S0[(n_) & 15] : S1[(n_) & 15])
#define DA_EXP2(i_) do { const float e0_ = __builtin_amdgcn_exp2f(DA_SX(2 * (i_))), e1_ = __builtin_amdgcn_exp2f(DA_SX(2 * (i_) + 1)); const da_bf16x2_t pk_ = __builtin_convertvector((f32x2){e0_, e1_}, da_bf16x2_t); lsum = __builtin_amdgcn_fdot2_f32_bf16(pk_, da_ones, lsum, false); PW[i_] = __builtin_bit_cast(unsigned, pk_); } while (0)
#define DA_PACK() do { P[0] = __builtin_bit_cast(bf16x8, (u32x4){PW[0], PW[1], PW[2], PW[3]}); P[1] = __builtin_bit_cast(bf16x8, (u32x4){PW[4], PW[5], PW[6], PW[7]}); \
                P[2] = __builtin_bit_cast(bf16x8, (u32x4){PW[8], PW[9], PW[10], PW[11]}); P[3] = __builtin_bit_cast(bf16x8, (u32x4){PW[12], PW[13], PW[14], PW[15]}); } while (0)
#define DA_PVX(kb_, SM) do { bf16x8 va[4], vb[4]; DA_LDVG(va, kb_, 0); \
                _Pragma("unroll") for (int k = 0; k < 4; ++k) { \
                    if (k == 0) DA_LDVG(vb, kb_, 1); else if (k == 1) DA_LDVG(va, kb_, 2); else if (k == 2) DA_LDVG(vb, kb_, 3); \
                    _Pragma("unroll") for (int dt = 0; dt < 4; ++dt) { \
                        O[dt] = __builtin_amdgcn_mfma_f32_32x32x16_bf16((k & 1) ? vb[dt] : va[dt], P[k], O[dt], 0, 0, 0); \
                        if (SM) DA_EXP2(4 * k + dt); \
                        __builtin_amdgcn_sched_barrier(0); } } } while (0)
#define DA_SYNC(t_) do { if ((t_) + 2 < NT) asm volatile("s_waitcnt vmcnt(4)" ::: "memory"); else asm volatile("s_waitcnt vmcnt(0)" ::: "memory");     \
                __builtin_amdgcn_s_barrier();                               \
                asm volatile("" ::: "memory"); \
                if ((t_) + 3 < NT) DA_ISSUE((t_) + 3, ((t_) + 3) & 3); } while (0)
            DA_ISSUE(0, 0); DA_ISSUE(1, 1);
            if (2 < NT) DA_ISSUE(2, 2);
            typedef __bf16 da_bf16x2_t __attribute__((ext_vector_type(2)));
            const da_bf16x2_t da_ones = {(__bf16)1.0f, (__bf16)1.0f};
            unsigned PW[16];
            { f32x16 S0, S1; bf16x8 kf[8];
              DA_SYNC(0);
              { const bool far = (63 + 113 <= q0 + 32 * g);
                DA_LDK(lds); __builtin_amdgcn_sched_barrier(0);
                DA_S(far ? c_far : c_near);
                if (!far) DA_BIAS(0);
#pragma unroll
                for (int i = 0; i < 16; ++i) DA_EXP2(i);
                DA_PACK(); }
              for (int t = 0; t < NT; ++t) {
                  if (t > 0) DA_SYNC(t);
                  if (t <= my_last) {
                      const LAS unsigned char* kbv = lds + (t & 3) * STG;
                      if (t + 1 <= my_last) {
                          const LAS unsigned char* kbk = lds + ((t + 1) & 3) * STG; const int key0 = (t + 1) * 64;
                          const bool far = (key0 + 63 + 113 <= q0 + 32 * g);
                          DA_LDK(kbk); __builtin_amdgcn_sched_barrier(0);
                          DA_S(far ? c_far : c_near);
                          if (!far) DA_BIAS(key0);
                          __builtin_amdgcn_sched_barrier(0);
                          DA_PVX(kbv, true);
                          DA_PACK();
                      } else { DA_PVX(kbv, false); }
                  }
              }
            }
#undef DA_SYNC
#undef DA_LDK
#undef DA_LDVG
#undef DA_S
#undef DA_BIAS
#undef DA_SX
#undef DA_EXP2
#undef DA_PACK
#undef DA_PVX
            { auto r1 = __builtin_amdgcn_permlane32_swap(__float_as_uint(lsum), __float_as_uint(lsum), false, false); lsum = __uint_as_float(r1[0]) + __uint_as_float(r1[1]); }
            __syncthreads();
            LAS float* xch = (LAS float*)(lds + g * 16384) + lane;
            if (c == 1) { const float i2 = lam / lsum;
#pragma unroll
                for (int dt = 0; dt < 4; ++dt)
#pragma unroll
                    for (int r = 0; r < 16; ++r) xch[(dt * 16 + r) * 64] = O[dt][r] * i2; }
            __syncthreads();
            if (c == 0) { const float i1 = 1.0f / lsum; float ss = 0.f;
#pragma unroll
                for (int dt = 0; dt < 4; ++dt)
#pragma unroll
                    for (int r = 0; r < 16; ++r) { const float o = O[dt][r] * i1 - xch[(dt * 16 + r) * 64]; O[dt][r] = o; ss += o * o; }
                auto r3 = __builtin_amdgcn_permlane32_swap(__float_as_uint(ss), __float_as_uint(ss), false, false); ss = __uint_as_float(r3[0]) + __uint_as_float(r3[1]);
                const float rstd = 0.8f / sqrtf(ss * (1.0f / 128.0f) + EPS);
                const float* sg = args.in[I_SUBG]; bf16_t* orow = AOUT + (tokbase + qpos) * D + 1024 + h * 128;
#pragma unroll
                for (int dt = 0; dt < 4; ++dt)
#pragma unroll
                    for (int g4 = 0; g4 < 4; ++g4) { const int d = 32 * dt + 8 * g4 + 4 * hh; const f32x4 gg = *(const f32x4*)(sg + d);
                        u32x2 wv; wv.x = pk2(O[dt][4 * g4] * rstd * gg[0], O[dt][4 * g4 + 1] * rstd * gg[1]); wv.y = pk2(O[dt][4 * g4 + 2] * rstd * gg[2], O[dt][4 * g4 + 3] * rstd * gg[3]);
                        *(u32x2*)(orow + d) = wv; }
            }
            __syncthreads();
        }
        }
#undef DA_ISSUE
    }
    SEAM(3);

    if (IN(4)) {
        pg8::Gemm g{D, D, D}; pg8::PlainOrder S; S.init(MIX, WOUT, D, D, T, D, G, bx);
        pg8::EpiH<true> E{args.in[I_X], XN, SSQ1w, 1.f, ws + WS_H8};
        pg8::gemm_phase(lds, g, S, E);
    }
    SEAM(4);

    if (IN(5)) {
        pg8::Gemm g{D / 2, D / 2, D / 2}; pg8::PlainOrder S; S.init(ws + WS_H8, WCQ, D / 2, D / 2, T, D, G, bx);
        pg8::EpiB<false, false, false, true> E{QC, D, 0, nullptr, 0, nullptr, 0.f, SSQQw, 4, 2, 1.0f / (A8_SCALE * W8_SCALE)};
        pg8::gemm_phase<true>(lds, g, S, E);
    }
    SEAM(5);

    if (IN(6)) {
        __syncthreads();
        if (wave == 0) { float a = 0.f, c = 0.f;
            for (int i = lane; i < 512; i += 64) { a = fmaxf(a, fabsf(args.in[I_CQG][i])); c = fmaxf(c, fabsf(args.in[I_CKG][i])); }
            a = wave_max(a); c = wave_max(c); if (lane == 0) ((LAS float*)(lds + RING_BYTES))[16] = 22.627416998f * a * c * LOG2E; }
        __syncthreads();
        const float cshift = ((LAS float*)(lds + RING_BYTES))[16];
        pg8::Gemm g{D, D, 512};
        pg8::BatchOrder S{(const char*)QC, (const char*)KC, D, D, 16, 1, 256, G, vcu, (size_t)SEQ * D * 2, 512 * 2, (size_t)MEML * D * 2, 512 * 2};
        pg8::EpiS E{PC, SSQ1, SSQQ, SSQK, LPART, cshift};
        pg8::gemm_phase(lds, g, S, E);
    }
    SEAM(6);

    if (IN(7)) {
        pg8::Gemm g{1024, MROWS, 256};
        pg8::BatchOrder S{(const char*)PC, (const char*)VCT, 1024, MROWS, 16, 2, 512, G, vcu, (size_t)SEQ * 1024 * 2, 256 * 2, 256 * 2, (size_t)512 * MROWS * 2};
        pg8::EpiPV E{(unsigned char*)MIX, LPART};
        pg8::gemm_phase(lds, g, S, E);
    }
    SEAM(7);

    if (IN(8)) {
        pg8::Gemm g{D / 2, D / 2, D / 2}; pg8::PlainOrder S; S.init(MIX, WCO, D / 2, D / 2, T, D, G, bx);
        pg8::EpiH<false> E{XN, XN, SSQ2w, dupscale * (1.0f / (OC8_SCALE * W8_SCALE))};
        pg8::gemm_phase<true>(lds, g, S, E);
    }
    SEAM(8);

    if (IN(9)) {
        pg8::Gemm g{D, D, D}; pg8::PlainOrder S; S.init(XN, WPQ, D, D, T, D, G, bx);
        pg8::EpiB<false, false, true, false> E{QP, D, 0, nullptr, 0, SSQ2, 1.0f / 2048.0f, nullptr, 0, 1};
        pg8::gemm_phase(lds, g, S, E);
    }
    SEAM(9);

    if (IN(10)) {
        constexpr size_t SLICE = (size_t)16384 * 128;
        LAS unsigned short* PIDX = (LAS unsigned short*)lds;
        LAS float* PGT = (LAS float*)(lds + 16384);
        LAS float* AACC = (LAS float*)(lds + 49152);
        LAS unsigned char* KSEL = lds + 81920;
        const unsigned char* U8 = ws + WS_U8; const unsigned char* V8 = ws + WS_V8; const float* USC = (const float*)(ws + WS_USC); const float* VSC = (const float*)(ws + WS_VSC);
        const int j = lane & 31, hh = lane >> 5;
        const int xcc = (int)xb_xcc_id();
        for (int tb = vcu; tb < T / 64; tb += G) {
            const int tok0 = tb * 64;
            __syncthreads();
            constexpr int sub = (VAR10 == 4) ? 0 : VAR10;
            if (sub >= 2) { for (int i = tid; i < 8192; i += 512) { PIDX[i] = (unsigned short)((i * 2654435761u >> 7) & 16383u); PGT[i] = 0.f; } }
            if (sub <= 1)
            for (int task = wave; task < 16; task += 8) {
                const int tgl = task >> 3, h = task & 7; const int tokl = 32 * tgl + j; const size_t tok = (size_t)tok0 + tokl;
                int L1[16], L2[16];
                peer_top16(QP + tok * D + h * 256 + 8 * hh, KEYS + ((size_t)(h * 2) * 128 + j) * 128 + 8 * hh, hh, L1);
                peer_top16(QP + tok * D + h * 256 + 128 + 8 * hh, KEYS + ((size_t)(h * 2 + 1) * 128 + j) * 128 + 8 * hh, hh, L2);
                float a1[16], a2[16];
#pragma unroll
                for (int i = 0; i < 16; ++i) { a1[i] = s2f(L1[i] & ~0x7f); a2[i] = s2f(L2[i] & ~0x7f); }
                int C0[16], C1[16], C2[16], C3[16];
#pragma unroll
                for (int i = 0; i < 16; ++i) { C0[i] = (int)0x80000000; C1[i] = (int)0x80000000; C2[i] = (int)0x80000000; C3[i] = (int)0x80000000; }
                { int n = 0;
#pragma unroll
                  for (int i = 0; i < 16; ++i)
#pragma unroll
                      for (int jj = 0; jj < 16; ++jj) if ((i + 1) * (jj + 1) <= 16) { const int v = (f2s(a1[i] + a2[jj]) & ~0xff) | (i << 4) | jj;
                          if (n < 16) C0[n & 15] = v; else if (n < 32) C1[n & 15] = v; else if (n < 48) C2[n & 15] = v; else C3[n & 15] = v; ++n; } }
                bitonic_sort16(C0); bitonic_sort16(C1); bitonic_sort16(C2); CEX(C3, 0, 1);
                merge_top16(C0, C1); merge_top16(C2, C3); merge_top16(C0, C2);
                int (&Lf)[16] = C0;
#pragma unroll
                for (int i = 0; i < 16; ++i) { KSEL[i * 512 + tid] = (unsigned char)(L1[i] & 0x7f); KSEL[8192 + i * 512 + tid] = (unsigned char)(L2[i] & 0x7f); }
                float sc16[16]; float sum = 0.f;
                const float smax = s2f(Lf[0] & ~0xff);
#pragma unroll
                for (int k = 0; k < 16; ++k) { sc16[k] = __expf(s2f(Lf[k] & ~0xff) - smax); sum += sc16[k]; }
                const float inv = 1.0f / sum;
                if (hh == 0) {
#pragma unroll
                    for (int k = 0; k < 16; ++k) { const int code = Lf[k] & 0xff; const int e = (int)KSEL[(code >> 4) * 512 + tid] * 128 + (int)KSEL[8192 + (code & 15) * 512 + tid];
                        PIDX[tokl * 128 + h * 16 + k] = (unsigned short)e; PGT[tokl * 128 + h * 16 + k] = sc16[k] * inv; }
                }
            }
#pragma unroll
            for (int i = 0; i < 16; ++i) AACC[wave * 1024 + i * 64 + lane] = 0.f;
            __syncthreads();
            if (sub == 0 || sub == 2)
            { const int ul = fresh_lane(); const int un = ul & 15, ukq = ul >> 4, uchi = ul & 3, urho = ul >> 2;
              const bool bon = ((ukq >> 1) == ((un >> 2) & 1)), bhi = (un >> 3) != 0;
              LAS unsigned char* XS = lds + 98304 + wave * 4096;
              u32x4 bufA[16], bufB[16]; u32x4 xr[4];
#pragma unroll
              for (int i = 0; i < 4; ++i) xr[i] = (u32x4){0u, 0u, 0u, 0u};
#define X_FETCH(rnd_) do { const int sl_ = (xcc + (rnd_)) & 7; const bf16_t* xp_ = XN + ((size_t)tok0 + wave * 8 + (ul >> 5)) * D + sl_ * 256 + (ul & 31) * 8; \
                  _Pragma("unroll") for (int i_ = 0; i_ < 4; ++i_) xr[i_] = *(const u32x4*)(xp_ + (size_t)(2 * i_) * D); } while (0)
#define X_PUT() do { LAS unsigned char* d_ = XS + (ul >> 5) * 256 + (ul & 31) * 8; _Pragma("unroll") for (int i_ = 0; i_ < 4; ++i_) { \
                      const f32x4 lo_ = (f32x4){bflo(xr[i_].x), bfhi(xr[i_].x), bflo(xr[i_].y), bfhi(xr[i_].y)} * XU_SCALE, hi_ = (f32x4){bflo(xr[i_].z), bfhi(xr[i_].z), bflo(xr[i_].w), bfhi(xr[i_].w)} * XU_SCALE; \
                      *(LAS u32x2*)(d_ + i_ * 512) = pack8_fp8(lo_, hi_); } } while (0)
#define U_LOAD(BUF, step_) do { const int r_ = (step_) >> 3, ti_ = (step_) & 7, sl_ = (xcc + r_) & 7, tokl_ = wave * 8 + ti_; \
                  const unsigned char* ub_ = U8 + (size_t)sl_ * SLICE; \
                  _Pragma("unroll") for (int g_ = 0; g_ < 8; ++g_) { const unsigned e_ = PIDX[tokl_ * 128 + 16 * g_ + urho]; \
                      BUF[2 * g_] = *(const u32x4*)(ub_ + (e_ * 128u + (unsigned)uchi * 16u)); BUF[2 * g_ + 1] = *(const u32x4*)(ub_ + (e_ * 128u + (unsigned)uchi * 16u + 64u)); } } while (0)
#define U_COMP(BUF, step_) do { const int ti_ = (step_) & 7, tokl_ = wave * 8 + ti_; \
                  const LAS unsigned char* xs_ = XS + ti_ * 256 + 32 * (un & 3) + 16 * (ukq & 1); u32x4 y0_ = (u32x4){0u, 0u, 0u, 0u}, y1_ = y0_; const u32x4 z_ = y0_; \
                  if (bon) { y0_ = *(const LAS u32x4*)(xs_); y1_ = *(const LAS u32x4*)(xs_ + 128); } \
                  const u32x4 x0_ = bhi ? z_ : y0_, x1_ = bhi ? y0_ : z_, x2_ = bhi ? z_ : y1_, x3_ = bhi ? y1_ : z_; \
                  const pg8::i32x8_t XB0 = (pg8::i32x8_t){(int)x0_.x, (int)x0_.y, (int)x0_.z, (int)x0_.w, (int)x1_.x, (int)x1_.y, (int)x1_.z, (int)x1_.w}, XB1 = (pg8::i32x8_t){(int)x2_.x, (int)x2_.y, (int)x2_.z, (int)x2_.w, (int)x3_.x, (int)x3_.y, (int)x3_.z, (int)x3_.w}; \
                  _Pragma("unroll") for (int g_ = 0; g_ < 8; ++g_) { f32x4 acc_ = (f32x4){0.f, 0.f, 0.f, 0.f}; \
                      const u32x4 a0_ = BUF[2 * g_], a1_ = BUF[2 * g_ + 1]; \
                      acc_ = __builtin_amdgcn_mfma_scale_f32_16x16x128_f8f6f4((pg8::i32x8_t){(int)a0_.x, (int)a0_.y, (int)a0_.z, (int)a0_.w, 0, 0, 0, 0}, XB0, acc_, 4, 0, 0, 0x7f7f7f7f, 0, 0x7f7f7f7f); \
                      acc_ = __builtin_amdgcn_mfma_scale_f32_16x16x128_f8f6f4((pg8::i32x8_t){(int)a1_.x, (int)a1_.y, (int)a1_.z, (int)a1_.w, 0, 0, 0, 0}, XB1, acc_, 4, 0, 0, 0x7f7f7f7f, 0, 0x7f7f7f7f); \
                      float v_ = (uchi == 0) ? acc_[0] : ((uchi == 1) ? acc_[1] : ((uchi == 2) ? acc_[2] : acc_[3])); \
                      v_ += __shfl_xor(v_, 1); v_ += __shfl_xor(v_, 2); \
                      if (uchi == 0) { LAS float* p_ = AACC + tokl_ * 128 + 16 * g_ + 4 * (un >> 2) + ukq; *p_ = *p_ + v_; } } } while (0)
              X_FETCH(0); X_PUT();
              U_LOAD(bufA, 0);
              for (int step = 0; step < 64; step += 2) {
                  U_LOAD(bufB, step + 1);
                  if ((step & 7) == 2 && step + 8 < 64) X_FETCH((step >> 3) + 1);
                  U_COMP(bufA, step);
                  if (step + 2 < 64) U_LOAD(bufA, step + 2);
                  U_COMP(bufB, step + 1);
                  if ((step & 7) == 6 && step + 2 < 64) X_PUT();
              }
#undef X_FETCH
#undef X_PUT
#undef U_LOAD
#undef U_COMP
            }
            LAS unsigned char* CF = lds + 81920;
            float iscv = 0.f;
            if (sub == 0) { const int cl = fresh_lane();
#pragma unroll 1
            for (int ti = 0; ti < 8; ++ti) {
                const int tokl = wave * 8 + ti; const size_t tok = (size_t)tok0 + tokl;
                const float rstd2 = stat_rstd(SSQ2[tok], 1.0f / 2048.0f);
                float cv[2];
#pragma unroll
                for (int k = 0; k < 2; ++k) { const int sl = tokl * 128 + k * 64 + cl; const unsigned e = PIDX[sl];
                    const float a = AACC[sl] * USC[e] * (rstd2 * (1.0f / XU_SCALE)); const float ge = 0.5f * a * (1.0f + erff(a * 0.70710678118654752f));
                    cv[k] = PGT[sl] * ge * VSC[e] * P10SCALE; }
                const float m = wave_max(fmaxf(fabsf(cv[0]), fabsf(cv[1])));
                const float sc = (m > 0.f) ? 448.0f / m : 1.0f;
                if (cl == ti) iscv = (m > 0.f) ? m * (1.0f / 448.0f) : 1.0f;
#pragma unroll
                for (int k = 0; k < 2; ++k) CF[tokl * 128 + k * 64 + cl] = (unsigned char)(__builtin_amdgcn_cvt_pk_fp8_f32(__builtin_amdgcn_fmed3f(cv[k] * sc, -448.0f, 448.0f), 0.f, 0, false) & 0xff);
            } }
            __syncthreads();
            if (sub == 0 || sub == 3)
            { const int vl = fresh_lane(); const int vr = vl & 15, vkq = vl >> 4;
              const unsigned lds0 = (unsigned)(size_t)lds;
              const unsigned bufw = (wave < 4) ? 16384u + (unsigned)wave * 16384u : 98304u + (unsigned)(wave - 4) * 16384u;
              const unsigned rbw = 90112u + (unsigned)wave * 1024u;
              const unsigned dch0 = (unsigned)((vl & 7) ^ (vl >> 4)) * 16u, dch1 = dch0 ^ 64u; const int dslot = vl >> 3;
              LAS unsigned char* const trb = lds + bufw + (unsigned)(32 * vkq + vr) * 128u; const unsigned fr = (unsigned)((vr >> 1) & 7);
              float* const outb = P10STORE ? args.out : (float*)(ws + WS_Z);
              typedef int v2i_t __attribute__((ext_vector_type(2)));
              float res[4] = {0.f, 0.f, 0.f, 0.f}; unsigned oprev = 0u;
#define V_GATHER(p_) do { const int sl_ = (xcc + ((p_) >> 3)) & 7; const unsigned char* vb_ = V8 + (size_t)sl_ * SLICE; const int tokl_ = wave * 8 + ((p_) & 7); \
                  _Pragma("unroll") for (int d_ = 0; d_ < 16; ++d_) { const unsigned e_ = PIDX[tokl_ * 128 + 8 * d_ + dslot]; \
                      glds16s((const void*)vb_, e_ * 128u + ((d_ & 1) ? dch1 : dch0), (unsigned)__builtin_amdgcn_readfirstlane((int)(lds0 + bufw + (unsigned)d_ * 1024u))); } } while (0)
#define V_RESID(p_) do { const int sl_ = (xcc + ((p_) >> 3)) & 7; const bf16_t* rb_ = XN + ((size_t)tok0 + wave * 8 + ((p_) & 7)) * D + sl_ * 256; \
                  if (vl < 32) glds16s((const void*)rb_, (unsigned)vl * 16u, (unsigned)__builtin_amdgcn_readfirstlane((int)(lds0 + rbw + (unsigned)((p_) & 1) * 512u))); } while (0)
#define V_STORE() do { asm volatile("global_store_dword %0, %1, %5 nt\n\tglobal_store_dword %0, %2, %5 offset:256 nt\n\tglobal_store_dword %0, %3, %5 offset:512 nt\n\tglobal_store_dword %0, %4, %5 offset:768 nt" \
                      :: "v"(oprev), "v"(res[0]), "v"(res[1]), "v"(res[2]), "v"(res[3]), "s"(outb) : "memory"); } while (0)
              V_GATHER(0); V_RESID(0);
#pragma unroll 1
              for (int p = 0; p < 64; ++p) {
                  asm volatile("s_waitcnt vmcnt(0)" ::: "memory");
                  const int tokl = wave * 8 + (p & 7);
                  u32x4 c0 = (u32x4){0u, 0u, 0u, 0u}, c1 = c0;
                  if ((vr & 3) == 0) { c0 = *(const LAS u32x4*)(CF + tokl * 128 + 16 * vkq); c1 = *(const LAS u32x4*)(CF + tokl * 128 + 16 * vkq + 64); }
                  v2i_t t0[16], t1[16];
#pragma unroll
                  for (int cb = 0; cb < 16; ++cb) { LAS unsigned char* q_ = trb + (((unsigned)(cb >> 1) ^ fr) * 16u) + 8 * (cb & 1);
                      t0[cb] = __builtin_amdgcn_ds_read_tr4_b64_v2i32((LAS v2i_t*)q_); t1[cb] = __builtin_amdgcn_ds_read_tr4_b64_v2i32((LAS v2i_t*)(q_ + 2048)); }
                  asm volatile("s_waitcnt lgkmcnt(0)" ::: "memory");
#pragma unroll
                  for (int cb = 0; cb < 16; ++cb) { asm volatile("" : "+v"(t0[cb]), "+v"(t1[cb])); }
                  if (p > 0) V_STORE();
                  if (p + 1 < 64) { V_GATHER(p + 1); V_RESID(p + 1); }
                  f32x4 acc[4];
#pragma unroll
                  for (int c = 0; c < 4; ++c) acc[c] = (f32x4){0.f, 0.f, 0.f, 0.f};
#pragma unroll
                  for (int g = 0; g < 4; ++g) { const bool on = (vr >> 2) == g;
                      const pg8::i32x8_t A = (pg8::i32x8_t){on ? (int)c0.x : 0, on ? (int)c0.y : 0, on ? (int)c0.z : 0, on ? (int)c0.w : 0, on ? (int)c1.x : 0, on ? (int)c1.y : 0, on ? (int)c1.z : 0, on ? (int)c1.w : 0};
#pragma unroll
                      for (int c = 0; c < 4; ++c) acc[c] = __builtin_amdgcn_mfma_scale_f32_16x16x128_f8f6f4(A, (pg8::i32x8_t){t0[4 * c + g].x, t0[4 * c + g].y, t1[4 * c + g].x, t1[4 * c + g].y, 0, 0, 0, 0}, acc[c], 0, 4, 0, 0x7f7f7f7f, 0, 0x7f7f7f7f); }
                  const float isc = __builtin_bit_cast(float, __builtin_amdgcn_readlane(__builtin_bit_cast(int, iscv), p & 7));
                  const int sl = (xcc + (p >> 3)) & 7; const LAS unsigned short* rb = (const LAS unsigned short*)(lds + rbw + (p & 1) * 512) + vl;
#pragma unroll
                  for (int c = 0; c < 4; ++c) res[c] = __builtin_bit_cast(float, (unsigned)rb[64 * c] << 16) + isc * acc[c][0];
                  oprev = (unsigned)(((size_t)tok0 + tokl) * D + sl * 256 + vl) * 4u;
              }
              V_STORE();
              asm volatile("s_waitcnt vmcnt(0)" ::: "memory");
#undef V_GATHER
#undef V_RESID
#undef V_STORE
            }
        }
    }
#undef IN
#undef SEAM
#undef GRID_BAR
}

extern "C" void kernel_launch(void* const* d_in, const int* in_sizes, int n_in, void* d_out, int out_size, void* d_ws, size_t ws_size, hipStream_t stream) {
    static int grid = 0;
    if (grid == 0) {
        if (n_in != 28 || out_size != T * D || ws_size < WS_END) { fprintf(stderr, "kernel_launch: unexpected problem (n_in %d, out %d, ws %zu)\n", n_in, out_size, ws_size); grid = -1; return; }
        int dev = 0, cus = 0;
        if (hipGetDevice(&dev) != hipSuccess || hipDeviceGetAttribute(&cus, hipDeviceAttributeMultiprocessorCount, dev) != hipSuccess) { grid = -1; return; }
        if (hipFuncSetAttribute((const void*)fwd_t<0>, hipFuncAttributeMaxDynamicSharedMemorySize, LDS_BYTES) != hipSuccess) { fprintf(stderr, "kernel_launch: hipFuncSetAttribute failed\n"); grid = -1; return; }
        int per_cu = 0;
        if (hipOccupancyMaxActiveBlocksPerMultiprocessor(&per_cu, (const void*)fwd_t<0>, 512, LDS_BYTES) != hipSuccess || per_cu < 1) { fprintf(stderr, "kernel_launch: occupancy query says %d\n", per_cu); }
        (void)hipGetLastError();
        grid = cus;
    }
    if (grid < 0) return;
    (void)hipMemsetAsync((char*)d_ws + WS_CTL, 0, CTL_BYTES, stream);
    Args a{};
    for (int i = 0; i < 28; ++i) a.in[i] = (const float*)d_in[i];
    a.out = (float*)d_out; a.ws = (unsigned char*)d_ws;
#if MK_SPLIT
    for (int p = 0; p < NPHASE; ++p) { a.ph_lo = p; a.ph_hi = p + 1; a.dup = 0; hipLaunchKernelGGL(fwd_t<0>, dim3(grid), dim3(512), LDS_BYTES, stream, a);
        if (p == DUP_PHASE) { a.dup = 1;
            if (DUP_PHASE == 10) { (void)hipFuncSetAttribute((const void*)fwd_t<0, (DUP_PHASE == 10 ? (DUP_SUB == 0 ? 4 : DUP_SUB) : 0)>, hipFuncAttributeMaxDynamicSharedMemorySize, LDS_BYTES); hipLaunchKernelGGL((fwd_t<0, (DUP_PHASE == 10 ? (DUP_SUB == 0 ? 4 : DUP_SUB) : 0)>), dim3(grid), dim3(512), LDS_BYTES, stream, a); }
            else if (DUP_PHASE == 3 && DUP_SUB != 0) { (void)hipFuncSetAttribute((const void*)fwd_t<(DUP_PHASE == 3 ? DUP_SUB : 0)>, hipFuncAttributeMaxDynamicSharedMemorySize, LDS_BYTES); hipLaunchKernelGGL(fwd_t<(DUP_PHASE == 3 ? DUP_SUB : 0)>, dim3(grid), dim3(512), LDS_BYTES, stream, a); }
            else hipLaunchKernelGGL(fwd_t<0>, dim3(grid), dim3(512), LDS_BYTES, stream, a);
            a.dup = 0; } }
#else
    a.ph_lo = 0; a.ph_hi = NPHASE;
    hipLaunchKernelGGL(fwd_t<0>, dim3(grid), dim3(512), LDS_BYTES, stream, a);
#endif
}
```

```cpp
#include <hip/hip_runtime.h>
#include <cstdio>
#include <cstdint>

#ifndef MK_SPLIT
#define MK_SPLIT 0
#endif
#ifndef DUP_SUB
#define DUP_SUB 0
#endif
#ifndef DUP_PHASE
#define DUP_PHASE -1
#endif

#define LAS __attribute__((address_space(3)))
#define GAS __attribute__((address_space(1)))
typedef unsigned short bf16_t;
typedef short bf16x8 __attribute__((ext_vector_type(8)));
typedef float f32x2 __attribute__((ext_vector_type(2)));
typedef float f32x4 __attribute__((ext_vector_type(4)));
typedef float f32x16 __attribute__((ext_vector_type(16)));
typedef unsigned u32x2 __attribute__((ext_vector_type(2)));
typedef unsigned u32x4 __attribute__((ext_vector_type(4)));
typedef unsigned long long u64;

constexpr int NB = 4, SEQ = 4096, T = NB * SEQ, D = 2048, MEML = 256, MROWS = NB * MEML;
constexpr float EPS = 1e-6f, LOG2E = 1.4426950408889634f;
constexpr float FX = 1048576.0f, FXI = 1.0f / 1048576.0f;

constexpr size_t MiB = 1u << 20;
constexpr size_t WS_CTL = 0, CTL_BYTES = 2 * MiB;
constexpr size_t WS_WIN = 2 * MiB, WS_WOUT = 22 * MiB, WS_WCQ = 30 * MiB, WS_WCKV = 38 * MiB, WS_WCO = 54 * MiB, WS_WPQ = 62 * MiB;
constexpr size_t WS_KEYS = 70 * MiB, WS_SGUW = 70 * MiB + 512 * 1024, WS_MISC = 71 * MiB;
constexpr size_t WS_MEMN = 72 * MiB, WS_KC = 76 * MiB, WS_VCT = 80 * MiB, WS_LPART = 84 * MiB;
constexpr size_t WS_XN = 86 * MiB;
constexpr size_t WS_Z = 150 * MiB;
constexpr size_t WS_QC = WS_Z, WS_PC = WS_Z + 64 * MiB, WS_QP = WS_Z, WS_H8 = WS_Z + 96 * MiB;
constexpr size_t WS_VT = 278 * MiB;
constexpr size_t WS_MIX = 310 * MiB;
constexpr size_t WS_U8 = 374 * MiB, WS_V8 = 406 * MiB, WS_END = 438 * MiB;
constexpr size_t WS_USC = WS_MISC + 256 * 1024, WS_VSC = WS_MISC + 320 * 1024;
constexpr int CW_BAR = 4096;
constexpr size_t CB_SSQ1 = 64 * 1024, CB_SSQ2 = 192 * 1024, CB_SSQK = 320 * 1024, CB_SSQQ = 512 * 1024;

constexpr int RING_BYTES = 131072, MISC_OFF = RING_BYTES + 320, LDS_BYTES = 163840;

__device__ __forceinline__ unsigned f2bf(float f) { unsigned u = __builtin_bit_cast(unsigned, f); return (u + 0x7fffu + ((u >> 16) & 1u)) >> 16; }
__device__ __forceinline__ unsigned pk2(float lo, float hi) { return f2bf(lo) | (f2bf(hi) << 16); }
__device__ __forceinline__ float bflo(unsigned w) { return __builtin_bit_cast(float, w << 16); }
__device__ __forceinline__ float bfhi(unsigned w) { return __builtin_bit_cast(float, w & 0xffff0000u); }
__device__ __forceinline__ unsigned cvt_pk_bf16(float lo, float hi) { unsigned r; asm volatile("v_cvt_pk_bf16_f32 %0, %1, %2" : "=v"(r) : "v"(lo), "v"(hi)); return r; }
__device__ __forceinline__ float wave_sum(float v) {
#pragma unroll
    for (int o = 1; o < 64; o <<= 1) v += __shfl_xor(v, o);
    return v;
}
__device__ __forceinline__ float wave_max(float v) {
#pragma unroll
    for (int o = 1; o < 64; o <<= 1) v = fmaxf(v, __shfl_xor(v, o));
    return v;
}
__device__ __forceinline__ float stat_rstd(u64 s, float inv_n) { return 1.0f / sqrtf((float)s * FXI * inv_n + EPS); }
__device__ __forceinline__ void stat_add(u64* p, float v) { __hip_atomic_fetch_add(p, (u64)(v * FX + 0.5f), __ATOMIC_RELAXED, __HIP_MEMORY_SCOPE_AGENT); }

__device__ __forceinline__ u32x2 pack8_fp8(f32x4 a, f32x4 b) {
#pragma unroll
    for (int i = 0; i < 4; ++i) { a[i] = __builtin_amdgcn_fmed3f(a[i], -448.0f, 448.0f); b[i] = __builtin_amdgcn_fmed3f(b[i], -448.0f, 448.0f); }
    int lo = __builtin_amdgcn_cvt_pk_fp8_f32(a[0], a[1], 0, false); lo = __builtin_amdgcn_cvt_pk_fp8_f32(a[2], a[3], lo, true);
    int hi = __builtin_amdgcn_cvt_pk_fp8_f32(b[0], b[1], 0, false); hi = __builtin_amdgcn_cvt_pk_fp8_f32(b[2], b[3], hi, true);
    return (u32x2){(unsigned)lo, (unsigned)hi};
}
constexpr float XU_SCALE = 16.0f;
constexpr float W8_SCALE = 2048.0f, A8_SCALE = 16.0f, OC8_SCALE = 64.0f;

__device__ __forceinline__ void glds16s(const void* sbase, unsigned voff, unsigned lds_dst) { unsigned keep;
    asm volatile("s_mov_b32 %0, m0\n\ts_mov_b32 m0, %3\n\ts_nop 0\n\tglobal_load_lds_dwordx4 %1, %2\n\ts_mov_b32 m0, %0" : "=&s"(keep) : "v"(voff), "s"(sbase), "s"(lds_dst) : "memory"); }

namespace pg8 {
constexpr int BM = 256, BK = 64, HALF = 128, HTB = HALF * BK * 2, STAGE_BYTES = 8 * HTB, NXCD = 8, WGM = 8;
__host__ __device__ __forceinline__ int lds_byte(int r, int c) { const int st = (r >> 4) * 2 + (c >> 5), rr = r & 15, cc = c & 31, ob = rr * 64 + cc * 2; return st * 1024 + (ob ^ (((ob >> 9) & 1) << 5)); }
__host__ __device__ __forceinline__ void stage_rc(int b, int& R, int& C) { const int st = b / 1024, sb = b % 1024, swz = sb ^ (((sb >> 9) & 1) << 5); R = (st >> 1) * 16 + swz / 64; C = (st & 1) * 32 + (swz % 64) / 2; }
__host__ __device__ __forceinline__ int perm32(int rho) { const int n = rho >> 4, i = rho & 15; return 8 * (i >> 2) + 4 * n + (i & 3); }

typedef int i32x8_t __attribute__((ext_vector_type(8)));
typedef short bf16x16_t __attribute__((ext_vector_type(16)));
struct Unit { const char* a; const char* b; int pm, pn, z; };
struct Gemm { int lda, ldb, K; };

struct PlainOrder {
    const char* A; const char* Bt; int lda, ldb, nM, nN, nwg, G, c;
    __device__ void init(const void* A_, const void* Bt_, int lda_, int ldb_, int M, int N, int G_, int c_) { A = (const char*)A_; Bt = (const char*)Bt_; lda = lda_; ldb = ldb_; nM = M / BM; nN = N / BM; nwg = nM * nN; G = G_; c = c_; }
    __device__ bool next(int i, Unit& u) const {
        const long L = (long)i * G + c; if (L >= nwg) return false;
        int wgid = (int)L; { const int q = nwg / NXCD, r = nwg % NXCD, xcd = wgid % NXCD, off = wgid / NXCD; wgid = (xcd < r ? xcd * (q + 1) : r * (q + 1) + (xcd - r) * q) + off; }
        const int nig = WGM * nN, gid = wgid / nig, fm = gid * WGM, gsz = (nM - fm) < WGM ? (nM - fm) : WGM;
        u.pm = fm + ((wgid % nig) % gsz); u.pn = (wgid % nig) / gsz; u.z = 0;
        u.a = A + (size_t)u.pm * BM * lda * 2; u.b = Bt + (size_t)u.pn * BM * ldb * 2; return true;
    }
    __device__ __forceinline__ void a_ready(const Unit&) const {}
    __device__ __forceinline__ void done(const Unit&) const {}
};
struct BatchOrder {
    const char* A; const char* Bt; int lda, ldb, nM, nN, nwg, G, v; size_t sAb, sAh, sBb, sBh;
    __device__ bool next(int i, Unit& u) const {
        const long L = (long)i * G + v; if (L >= nwg) return false;
        const int per = nM * nN, z = (int)L / per, rem = (int)L % per;
        u.z = z; u.pm = rem / nN; u.pn = rem % nN;
        u.a = A + (size_t)(z >> 2) * sAb + (size_t)(z & 3) * sAh + (size_t)u.pm * BM * lda * 2;
        u.b = Bt + (size_t)(z >> 2) * sBb + (size_t)(z & 3) * sBh + (size_t)u.pn * BM * ldb * 2; return true;
    }
    __device__ __forceinline__ void a_ready(const Unit&) const {}
    __device__ __forceinline__ void done(const Unit&) const {}
};
struct PairOrder {
    const char *A0, *B0, *A1, *B1; int lda, ldb, nM0, nN0, nM1, nN1, G, v;
    __device__ bool next(int i, Unit& u) const {
        const int L = i * G + v; const int n0 = nM0 * nN0, n1 = nM1 * nN1; if (L >= n0 + n1) return false;
        if (L < n0) { u.z = 0; u.pm = L / nN0; u.pn = L % nN0; u.a = A0 + (size_t)u.pm * BM * lda * 2; u.b = B0 + (size_t)u.pn * BM * ldb * 2; }
        else { const int r = L - n0; u.z = 1; u.pm = r / nN1; u.pn = r % nN1; u.a = A1 + (size_t)u.pm * BM * lda * 2; u.b = B1 + (size_t)u.pn * BM * ldb * 2; }
        return true;
    }
    __device__ __forceinline__ void a_ready(const Unit&) const {}
    __device__ __forceinline__ void done(const Unit&) const {}
};

__device__ __forceinline__ f32x2 gelu_pk(f32x2 v) {
    const f32x2 av = __builtin_elementwise_abs(v), d = av * 0.2316418882f + 1.0f;
    f32x2 t; t.x = __builtin_amdgcn_rcpf(d.x); t.y = __builtin_amdgcn_rcpf(d.y);
    f32x2 q = t * 0.5307027145f + (-0.7265760135f); q = q * t + 0.7107068705f; q = q * t + (-0.142248368f); q = q * t + 0.127414796f; q = q * t;
    const f32x2 s = (v * v) * (-0.72134752044f);
    f32x2 e; e.x = __builtin_amdgcn_exp2f(s.x); e.y = __builtin_amdgcn_exp2f(s.y);
    const f32x2 m = v * (q * e), r = v - m;
    f32x2 o; o.x = v.x < 0.f ? m.x : r.x; o.y = v.y < 0.f ? m.y : r.y; return o;
}
__device__ __forceinline__ f32x4 gelu4(f32x4 v) { const f32x2 a = gelu_pk((f32x2){v[0], v[1]}), b = gelu_pk((f32x2){v[2], v[3]}); return (f32x4){a.x, a.y, b.x, b.y}; }

template <bool GELU, bool COLS, bool ROWS, bool SSQ> struct EpiB {
    static constexpr bool PERM = true;
    bf16_t* O; int ldc; int gelu_pn; const float* cs; int cmask; const u64* rssq; float r_inv_n; u64* ssq; int nh; int tph; float oscale = 1.0f;
    __device__ __forceinline__ void operator()(const f32x4 (&acc)[2][2][4][2], const Unit& u, int wr, int wc, int fr, int fq) const {
        const int row0 = u.pm * BM + wr * 64 + fr, col0 = u.pn * BM + wc * 32 + 8 * fq;
        const bool dog = GELU && (u.pn < gelu_pn);
        f32x4 cv[2][2];
        if (COLS) {
#pragma unroll
            for (int bj = 0; bj < 2; ++bj)
#pragma unroll
                for (int n = 0; n < 2; ++n) cv[bj][n] = *(const f32x4*)(cs + ((col0 + bj * HALF + 4 * n) & cmask));
        }
#pragma unroll
        for (int ai = 0; ai < 2; ++ai)
#pragma unroll
            for (int m = 0; m < 4; ++m) {
                const int row = row0 + ai * HALF + m * 16; bf16_t* rowp = O + (size_t)row * ldc + col0;
                float rs = 1.f; if (ROWS) rs = stat_rstd(rssq[row], r_inv_n);
                float s = 0.f;
#pragma unroll
                for (int bj = 0; bj < 2; ++bj) { f32x4 v0 = acc[ai][bj][m][0] * oscale, v1 = acc[ai][bj][m][1] * oscale;
                    if (SSQ) s += (v0[0] * v0[0] + v0[1] * v0[1]) + (v0[2] * v0[2] + v0[3] * v0[3]) + (v1[0] * v1[0] + v1[1] * v1[1]) + (v1[2] * v1[2] + v1[3] * v1[3]);
                    if (GELU) { if (dog) { v0 = gelu4(v0); v1 = gelu4(v1); } }
                    if (COLS) { v0 = v0 * cv[bj][0]; v1 = v1 * cv[bj][1]; }
                    if (ROWS) { v0 = v0 * rs; v1 = v1 * rs; }
                    u32x4 w; w.x = cvt_pk_bf16(v0[0], v0[1]); w.y = cvt_pk_bf16(v0[2], v0[3]); w.z = cvt_pk_bf16(v1[0], v1[1]); w.w = cvt_pk_bf16(v1[2], v1[3]);
                    *(u32x4*)(rowp + bj * HALF) = w; }
                if (SSQ) { s += __shfl_xor(s, 16); s += __shfl_xor(s, 32); if (fq == 0) stat_add(ssq + (size_t)row * nh + u.pn / tph, s); }
            }
    }
};
struct EpiKV {
    static constexpr bool PERM = true;
    bf16_t* KC; bf16_t* VCT; const float* kgqg; u64* ssqk;
    __device__ __forceinline__ void operator()(const f32x4 (&acc)[2][2][4][2], const Unit& u, int wr, int wc, int fr, int fq) const {
        const int row0 = u.pm * BM + wr * 64 + fr, col0 = u.pn * BM + wc * 32 + 8 * fq;
        if (u.z == 0) { EpiB<false, true, false, true> e{KC, D, 0, kgqg, 511, nullptr, 0.f, ssqk, 4, 2}; e(acc, u, wr, wc, fr, fq); }
        else { EpiB<false, false, false, false> e{VCT, MROWS, 0, nullptr, 0, nullptr, 0.f, nullptr, 0, 1}; e(acc, u, wr, wc, fr, fq); }
        (void)row0; (void)col0;
    }
};
template <bool XF32> struct EpiH {
    static constexpr bool PERM = true;
    const void* base; bf16_t* H; u64* ssq; float accscale; unsigned char* H8 = nullptr;
    __device__ __forceinline__ void operator()(const f32x4 (&acc)[2][2][4][2], const Unit& u, int wr, int wc, int fr, int fq) const {
        const int row0 = u.pm * BM + wr * 64 + fr, col0 = u.pn * BM + wc * 32 + 8 * fq;
#pragma unroll
        for (int ai = 0; ai < 2; ++ai)
#pragma unroll
            for (int m = 0; m < 4; ++m) {
                const int row = row0 + ai * HALF + m * 16; const size_t off = (size_t)row * D + col0; float s = 0.f;
#pragma unroll
                for (int bj = 0; bj < 2; ++bj) {
                    f32x4 b0, b1;
                    if (XF32) { const float* xp = (const float*)base + off + bj * HALF; b0 = *(const f32x4*)xp; b1 = *(const f32x4*)(xp + 4); }
                    else { const u32x4 w = *(const u32x4*)((const bf16_t*)base + off + bj * HALF); b0 = (f32x4){bflo(w.x), bfhi(w.x), bflo(w.y), bfhi(w.y)}; b1 = (f32x4){bflo(w.z), bfhi(w.z), bflo(w.w), bfhi(w.w)}; }
                    const f32x4 h0 = b0 + acc[ai][bj][m][0] * accscale, h1 = b1 + acc[ai][bj][m][1] * accscale;
                    s += (h0[0] * h0[0] + h0[1] * h0[1]) + (h0[2] * h0[2] + h0[3] * h0[3]) + (h1[0] * h1[0] + h1[1] * h1[1]) + (h1[2] * h1[2] + h1[3] * h1[3]);
                    u32x4 o; o.x = cvt_pk_bf16(h0[0], h0[1]); o.y = cvt_pk_bf16(h0[2], h0[3]); o.z = cvt_pk_bf16(h1[0], h1[1]); o.w = cvt_pk_bf16(h1[2], h1[3]);
                    *(u32x4*)(H + off + bj * HALF) = o;
                    if (H8) *(u32x2*)(H8 + off + bj * HALF) = pack8_fp8(h0 * A8_SCALE, h1 * A8_SCALE); }
                s += __shfl_xor(s, 16); s += __shfl_xor(s, 32); if (fq == 0) stat_add(ssq + row, s);
                asm volatile("" ::: "memory");
            }
    }
};
struct EpiS {
    static constexpr bool PERM = true;
    bf16_t* P; const u64* ssq1; const u64* ssqq; const u64* ssqk; float* lpart; float cshift;
    __device__ __forceinline__ void operator()(const f32x4 (&acc)[2][2][4][2], const Unit& u, int wr, int wc, int fr, int fq) const {
        const int b = u.z >> 2, h = u.z & 3;
        const int row0 = b * SEQ + u.pm * BM + wr * 64 + fr, key0 = wc * 32 + 8 * fq;
        float fk[2][2][4];
#pragma unroll
        for (int bj = 0; bj < 2; ++bj)
#pragma unroll
            for (int n = 0; n < 2; ++n)
#pragma unroll
                for (int e = 0; e < 4; ++e) fk[bj][n][e] = stat_rstd(ssqk[(size_t)(b * MEML + key0 + bj * HALF + 4 * n + e) * 4 + h], 1.0f / 512.0f);
#pragma unroll
        for (int ai = 0; ai < 2; ++ai)
#pragma unroll
            for (int m = 0; m < 4; ++m) {
                const int row = row0 + ai * HALF + m * 16;
                const float r1 = stat_rstd(ssq1[row], 1.0f / 2048.0f);
                const float sq = (float)ssqq[(size_t)row * 4 + h] * FXI;
                const float rq = 1.0f / sqrtf(r1 * r1 * sq * (1.0f / 512.0f) + EPS);
                const float fr_ = r1 * rq * (0.044194173824159216f * LOG2E);
                float s = 0.f; bf16_t* rowp = P + (size_t)row * 1024 + h * 256 + key0;
#pragma unroll
                for (int bj = 0; bj < 2; ++bj) { float p[8];
#pragma unroll
                    for (int n = 0; n < 2; ++n)
#pragma unroll
                        for (int e = 0; e < 4; ++e) { p[4 * n + e] = __builtin_amdgcn_exp2f(acc[ai][bj][m][n][e] * fr_ * fk[bj][n][e] - cshift); s += p[4 * n + e]; }
                    u32x4 w; w.x = cvt_pk_bf16(p[0], p[1]); w.y = cvt_pk_bf16(p[2], p[3]); w.z = cvt_pk_bf16(p[4], p[5]); w.w = cvt_pk_bf16(p[6], p[7]);
                    *(u32x4*)(rowp + bj * HALF) = w; }
                s += __shfl_xor(s, 16); s += __shfl_xor(s, 32); if (fq == 0) lpart[((size_t)row * 4 + h) * 4 + wc] = s;
            }
    }
};
struct EpiPV {
    static constexpr bool PERM = true;
    unsigned char* O; const float* lpart;
    __device__ __forceinline__ void operator()(const f32x4 (&acc)[2][2][4][2], const Unit& u, int wr, int wc, int fr, int fq) const {
        const int b = u.z >> 2, h = u.z & 3;
        const int row0 = b * SEQ + u.pm * BM + wr * 64 + fr, col0 = h * 512 + u.pn * BM + wc * 32 + 8 * fq;
#pragma unroll
        for (int ai = 0; ai < 2; ++ai)
#pragma unroll
            for (int m = 0; m < 4; ++m) {
                const int row = row0 + ai * HALF + m * 16; const f32x4 lp = *(const f32x4*)(lpart + ((size_t)row * 4 + h) * 4);
                const float inv = OC8_SCALE / ((lp[0] + lp[1]) + (lp[2] + lp[3])); unsigned char* rowp = O + (size_t)row * D + col0;
#pragma unroll
                for (int bj = 0; bj < 2; ++bj) *(u32x2*)(rowp + bj * HALF) = pack8_fp8(acc[ai][bj][m][0] * inv, acc[ai][bj][m][1] * inv);
            }
    }
};

template <bool FP8 = false, class Epi, class Sched, bool ALIGN_EPI = true>
__device__ __forceinline__ void gemm_phase(LAS unsigned char* lds, const Gemm g, const Sched& S, const Epi& E) {
    const int tid = threadIdx.x, wid = __builtin_amdgcn_readfirstlane(tid >> 6), lane = tid & 63, wr = wid >> 2, wc = wid & 3, fr = lane & 15, fq = lane >> 4;
    const int K = g.K, nt = K / BK;
    unsigned voffA[2], voffB[2];
#pragma unroll
    for (int i = 0; i < 2; ++i) { int R, C; stage_rc(tid * 16 + i * 8192, R, C); const int Rb = Epi::PERM ? ((R & ~31) + perm32(R & 31)) : R;
        voffA[i] = (unsigned)(R * g.lda + C) * 2u; voffB[i] = (unsigned)(Rb * g.ldb + C) * 2u; }
    const size_t kstep = (size_t)(BK * 2);
    const size_t hstepA = (size_t)HALF * g.lda * 2, hstepB = (size_t)HALF * g.ldb * 2;
    const unsigned ldsw = (unsigned)wid * 1024u; const unsigned lds0 = (unsigned)(size_t)lds;
    const int aoff = lds_byte(wr * 64 + fr, fq * 8), boff = lds_byte(wc * 32 + fr, fq * 8);
#define PG8_SA(b, h) (((b) * 2 + (h)) * HTB)
#define PG8_SB(b, h) ((4 + (b) * 2 + (h)) * HTB)
#define PG8_STAGE(bufoff, gbase, voff) do { _Pragma("unroll") for (int _i = 0; _i < 2; ++_i) \
        glds16s((const void*)(gbase), (voff)[_i], (unsigned)__builtin_amdgcn_readfirstlane((int)(lds0 + (unsigned)(bufoff) + ldsw + (unsigned)_i * 8192u))); } while (0)
#define PG8_LDA(dst, b, h) do { _Pragma("unroll") for (int m = 0; m < 4; ++m) { dst[m].lo = *(const LAS bf16x8*)(lds + PG8_SA(b, h) + aoff + m * 2048); dst[m].hi = *(const LAS bf16x8*)(lds + PG8_SA(b, h) + aoff + m * 2048 + 1024); } } while (0)
#define PG8_LDB(dst, b, h) do { _Pragma("unroll") for (int n = 0; n < 2; ++n) { dst[n].lo = *(const LAS bf16x8*)(lds + PG8_SB(b, h) + boff + n * 2048); dst[n].hi = *(const LAS bf16x8*)(lds + PG8_SB(b, h) + boff + n * 2048 + 1024); } } while (0)
#define PG8_MMA(ai, bj, At, Bt) do { __builtin_amdgcn_s_setprio(1); _Pragma("unroll") for (int m = 0; m < 4; ++m) _Pragma("unroll") for (int n = 0; n < 2; ++n) { \
        if constexpr (FP8) asm volatile("v_mfma_scale_f32_16x16x128_f8f6f4 %0, %1, %2, %0, %3, %3 op_sel_hi:[0,0,0]" : "+v"(acc[ai][bj][m][n]) : "v"(__builtin_bit_cast(i32x8_t, Bt[n])), "v"(__builtin_bit_cast(i32x8_t, At[m])), "v"(0x7f7f7f7f));   \
        else { acc[ai][bj][m][n] = __builtin_amdgcn_mfma_f32_16x16x32_bf16(Bt[n].lo, At[m].lo, acc[ai][bj][m][n], 0, 0, 0); acc[ai][bj][m][n] = __builtin_amdgcn_mfma_f32_16x16x32_bf16(Bt[n].hi, At[m].hi, acc[ai][bj][m][n], 0, 0, 0); } } \
        __builtin_amdgcn_s_setprio(0); } while (0)
#define PG8_WAIT_V(n) asm volatile("s_waitcnt vmcnt(" #n ")" ::: "memory")
#define PG8_WAIT_L(n) asm volatile("s_waitcnt lgkmcnt(" #n ")" ::: "memory")
#define PG8_BAR __builtin_amdgcn_s_barrier()
#define PG8_SCHED __builtin_amdgcn_sched_barrier(0)
    Unit cur, nxt; int ui = 0;
    if (!S.next(0, cur)) return;
    f32x4 acc[2][2][4][2];
#pragma unroll
    for (int a = 0; a < 2; ++a)
#pragma unroll
        for (int b = 0; b < 2; ++b)
#pragma unroll
            for (int m = 0; m < 4; ++m)
#pragma unroll
                for (int n = 0; n < 2; ++n) acc[a][b][m][n] = (f32x4){0.f, 0.f, 0.f, 0.f};
    bf16x16_t At[4], B0[2], B1[2];
    const char* cA = cur.a; const char* cB = cur.b;
    S.a_ready(cur);
    PG8_STAGE(PG8_SB(0, 0), cB, voffB); PG8_STAGE(PG8_SB(0, 1), cB + hstepB, voffB); PG8_STAGE(PG8_SA(0, 0), cA, voffA); PG8_STAGE(PG8_SA(0, 1), cA + hstepA, voffA);
    if (wr == 1) PG8_BAR;
    PG8_WAIT_V(2); PG8_BAR;
    PG8_STAGE(PG8_SB(1, 0), cB + kstep, voffB); PG8_STAGE(PG8_SA(1, 0), cA + kstep, voffA); PG8_STAGE(PG8_SB(1, 1), cB + hstepB + kstep, voffB);
    PG8_WAIT_V(6); PG8_BAR;
    for (;;) {
        const bool has_next = S.next(ui + 1, nxt);
        const char* nA = has_next ? nxt.a : cA; const char* nB = has_next ? nxt.b : cB;
        for (int t = 0; t < nt; t += 2) {
            const bool last = (t == nt - 2);
            const char* a1 = cA + (size_t)(t + 1) * kstep;
            const char* a2 = last ? nA : cA + (size_t)(t + 2) * kstep; const char* b2 = last ? nB : cB + (size_t)(t + 2) * kstep;
            const char* a3 = a2 + kstep; const char* b3 = b2 + kstep;
            if (last && has_next) S.a_ready(nxt);
            PG8_LDB(B0, 0, 0); PG8_LDB(B1, 0, 1); PG8_SCHED; PG8_LDA(At, 0, 0); PG8_STAGE(PG8_SA(1, 1), a1 + hstepA, voffA);
            PG8_WAIT_V(8); PG8_WAIT_L(0); PG8_BAR; PG8_MMA(0, 0, At, B0); PG8_MMA(0, 1, At, B1); PG8_BAR; PG8_SCHED;
            PG8_LDA(At, 0, 1); PG8_STAGE(PG8_SB(0, 0), b2, voffB); PG8_STAGE(PG8_SB(0, 1), b2 + hstepB, voffB); PG8_STAGE(PG8_SA(0, 0), a2, voffA);
            PG8_WAIT_V(8); PG8_WAIT_L(0); PG8_BAR; PG8_MMA(1, 0, At, B0); PG8_MMA(1, 1, At, B1); PG8_BAR; PG8_SCHED;
            PG8_LDB(B0, 1, 0); PG8_LDB(B1, 1, 1); PG8_SCHED; PG8_LDA(At, 1, 0); PG8_STAGE(PG8_SA(0, 1), a2 + hstepA, voffA);
            PG8_WAIT_V(8); PG8_WAIT_L(0); PG8_BAR; PG8_MMA(0, 0, At, B0); PG8_MMA(0, 1, At, B1); PG8_BAR; PG8_SCHED;
            PG8_LDA(At, 1, 1); PG8_STAGE(PG8_SB(1, 0), b3, voffB); PG8_STAGE(PG8_SB(1, 1), b3 + hstepB, voffB); PG8_STAGE(PG8_SA(1, 0), a3, voffA);
            PG8_WAIT_V(8); PG8_WAIT_L(0); PG8_BAR; PG8_MMA(1, 0, At, B0); PG8_MMA(1, 1, At, B1); PG8_BAR; PG8_SCHED;
        }
        if constexpr (ALIGN_EPI) { if (wr == 0) PG8_BAR; }
        if constexpr (FP8) asm volatile("s_nop 15\n\ts_nop 15" ::: "memory");
        E(acc, cur, wr, wc, fr, fq); S.done(cur);
        if (!has_next) break;
#pragma unroll
        for (int a = 0; a < 2; ++a)
#pragma unroll
            for (int b = 0; b < 2; ++b)
#pragma unroll
                for (int m = 0; m < 4; ++m)
#pragma unroll
                    for (int n = 0; n < 2; ++n) acc[a][b][m][n] = (f32x4){0.f, 0.f, 0.f, 0.f};
        cur = nxt; cA = nA; cB = nB; ++ui;
        if constexpr (ALIGN_EPI) { if (wr == 1) PG8_BAR; }
    }
    PG8_WAIT_V(0);
    if constexpr (!ALIGN_EPI) { if (wr == 0) PG8_BAR; }
    PG8_BAR;
#undef PG8_SA
#undef PG8_SB
#undef PG8_STAGE
#undef PG8_LDA
#undef PG8_LDB
#undef PG8_MMA
#undef PG8_WAIT_V
#undef PG8_WAIT_L
#undef PG8_BAR
#undef PG8_SCHED
}
}

#define XB_TMO      128
#define XB_XCNT(j)  (256  + 64 * (j))
#define XB_XSUB(j)  (1280 + 64 * (j))
#define XB_XGEN(j)  (2304 + 64 * (j))
#define XB_TOP      3328
#define XB_TOPGEN   3392
#define XCD_BAR_WORDS 3456
#define XB_SPIN_CAP (1u << 18)
__device__ __forceinline__ unsigned xb_ld(unsigned* p)              { return __hip_atomic_load(p, __ATOMIC_RELAXED, __HIP_MEMORY_SCOPE_AGENT); }
__device__ __forceinline__ unsigned xb_add(unsigned* p, unsigned v) { return __hip_atomic_fetch_add(p, v, __ATOMIC_RELAXED, __HIP_MEMORY_SCOPE_AGENT); }
__device__ __forceinline__ unsigned xb_xcc_id() { return (unsigned)__builtin_amdgcn_s_getreg((3 << 11) | 20) & 0xFu; }
#define XB_SPIN(cond, bar) do { unsigned _sp = 0; while (cond) { __builtin_amdgcn_s_sleep(1); \
    if ((++_sp & 255u) == 0u) { if (xb_ld(&(bar)[XB_TMO])) break; if (_sp > XB_SPIN_CAP) { atomicAdd(&(bar)[XB_TMO], 1u); break; } } } } while (0)
struct XcdBarrier { unsigned* bar; unsigned x; volatile LAS unsigned* st; };
__device__ __forceinline__ XcdBarrier xcd_barrier_post(unsigned* bar, volatile LAS unsigned* st) {
    XcdBarrier b; b.bar = bar; b.x = xb_xcc_id(); b.st = st;
    if (threadIdx.x == 0) (void)xb_add(&bar[XB_XCNT(b.x)], 1u);
    return b;
}
__device__ __forceinline__ void xcd_barrier_complete(unsigned* bar, unsigned x, unsigned& nloc, unsigned& nx) {
    const unsigned G = gridDim.x * gridDim.y * gridDim.z;
    unsigned sum, cnt, mine, sp = 0u;
    for (;;) {
        sum = 0u; cnt = 0u; mine = 0u;
#pragma unroll
        for (unsigned j = 0; j < 16; ++j) { const unsigned c = xb_ld(&bar[XB_XCNT(j)]); sum += c; cnt += (c > 0u) ? 1u : 0u; mine = (j == x) ? c : mine; }
        if (sum == G) break;
        __builtin_amdgcn_s_sleep(1);
        if ((++sp & 255u) == 0u) { if (xb_ld(&bar[XB_TMO])) break; if (sp > XB_SPIN_CAP) { atomicAdd(&bar[XB_TMO], 1u); break; } }
    }
    nloc = mine > 0u ? mine : 1u; nx = cnt > 0u ? cnt : 1u;
}
__device__ __forceinline__ void xcd_barrier(const XcdBarrier& b) {
    asm volatile("s_waitcnt vmcnt(0)" ::: "memory");
    __syncthreads();
    if (threadIdx.x == 0) {
        unsigned* bar = b.bar;
        __builtin_amdgcn_s_waitcnt(0);
        unsigned nloc = b.st[0], nx = b.st[1];
        if (nloc == 0u) { xcd_barrier_complete(bar, b.x, nloc, nx); b.st[0] = nloc; b.st[1] = nx; }
        const unsigned old = xb_add(&bar[XB_XSUB(b.x)], 1u);
        const unsigned gen = old / nloc;
        if (old + 1u == (gen + 1u) * nloc) {
            __builtin_amdgcn_fence(__ATOMIC_RELEASE, "agent");
            asm volatile("s_waitcnt vmcnt(0)" ::: "memory");
            const unsigned og = xb_add(&bar[XB_TOP], 1u);
            const unsigned tg = og / nx;
            if (og + 1u == (tg + 1u) * nx) xb_add(&bar[XB_TOPGEN], 1u);
            else XB_SPIN(xb_ld(&bar[XB_TOPGEN]) == tg, bar);
            __builtin_amdgcn_fence(__ATOMIC_ACQUIRE, "agent");
            xb_add(&bar[XB_XGEN(b.x)], 1u);
            asm volatile("s_waitcnt vmcnt(0)" ::: "memory");
        } else {
            XB_SPIN(xb_ld(&bar[XB_XGEN(b.x)]) == gen, bar);
            __builtin_amdgcn_fence(__ATOMIC_ACQUIRE, "agent");
            asm volatile("s_waitcnt vmcnt(0)" ::: "memory");
        }
    }
    __syncthreads();
}

struct Args { const float* in[28]; float* out; unsigned char* ws; int ph_lo, ph_hi, dup, pad; };
enum { I_X = 0, I_MEM, I_NMIXG, I_WIN, I_SGUNG, I_SGUW, I_SGUB, I_QNG, I_KNG, I_LQ1, I_LK1, I_LQ2, I_LK2, I_SUBG, I_RELB, I_WOUT, I_NCG, I_NMG, I_WCQ, I_WCKV, I_CQG, I_CKG, I_WCO, I_NFG, I_PWQ, I_PKEYS, I_PU, I_PV };
constexpr int NPHASE = 11;

template <bool GAIN, bool OUT8 = false> __device__ __forceinline__ void p0_transpose_item(const float* W, int K, int N, bf16_t* WT, LAS float* scr, int item, int lane, const float* gk = nullptr) {
    const int nblk = N / 32, kb = item / nblk, nb = item % nblk, k0 = 64 * kb, n0 = 32 * nb;
#pragma unroll 16
    for (int i = 0; i < 32; ++i) { const int kk = 2 * i + (lane >> 5); scr[kk * 33 + (lane & 31)] = W[(size_t)(k0 + kk) * N + n0 + (lane & 31)]; }
    const int c = lane & 7;
    f32x4 g0 = (f32x4){1.f, 1.f, 1.f, 1.f}, g1 = g0;
    if (GAIN) { g0 = *(const f32x4*)(gk + k0 + 8 * c); g1 = *(const f32x4*)(gk + k0 + 8 * c + 4); }
    asm volatile("s_waitcnt lgkmcnt(0)" ::: "memory");
#pragma unroll
    for (int j = 0; j < 4; ++j) { const int n = (lane >> 3) + 8 * j; const LAS float* s = scr + (8 * c) * 33 + n;
        u32x4 o; o.x = pk2(s[0 * 33] * g0[0], s[1 * 33] * g0[1]); o.y = pk2(s[2 * 33] * g0[2], s[3 * 33] * g0[3]); o.z = pk2(s[4 * 33] * g1[0], s[5 * 33] * g1[1]); o.w = pk2(s[6 * 33] * g1[2], s[7 * 33] * g1[3]);
        if (OUT8) *(u32x2*)((unsigned char*)WT + (size_t)(n0 + n) * K + k0 + 8 * c) = pack8_fp8((f32x4){s[0 * 33] * g0[0], s[1 * 33] * g0[1], s[2 * 33] * g0[2], s[3 * 33] * g0[3]} * W8_SCALE, (f32x4){s[4 * 33] * g1[0], s[5 * 33] * g1[1], s[6 * 33] * g1[2], s[7 * 33] * g1[3]} * W8_SCALE);
        else *(u32x4*)(WT + (size_t)(n0 + n) * K + k0 + 8 * c) = o; }
    asm volatile("s_waitcnt lgkmcnt(0)" ::: "memory");
}
__device__ __forceinline__ void rms_row_to_bf16(const float* xrow, const float* g, bf16_t* orow, int lane, unsigned char* o8row = nullptr) {
    const f32x4* xr = (const f32x4*)xrow + lane; const f32x4* gr = (const f32x4*)g + lane;
    f32x4 v[8]; float s = 0.f;
#pragma unroll
    for (int j = 0; j < 8; ++j) { v[j] = xr[64 * j]; s += (v[j][0] * v[j][0] + v[j][1] * v[j][1]) + (v[j][2] * v[j][2] + v[j][3] * v[j][3]); }
    const float rstd = 1.0f / sqrtf(wave_sum(s) * (1.0f / 2048.0f) + EPS);
    u32x2* o8 = (u32x2*)orow + lane;
#pragma unroll
    for (int j = 0; j < 8; ++j) { const f32x4 gg = gr[64 * j]; const f32x4 y = (f32x4){v[j][0] * rstd * gg[0], v[j][1] * rstd * gg[1], v[j][2] * rstd * gg[2], v[j][3] * rstd * gg[3]};
        u32x2 w; w.x = pk2(y[0], y[1]); w.y = pk2(y[2], y[3]); o8[64 * j] = w;
        if (o8row) { f32x4 z = y * A8_SCALE;
#pragma unroll
            for (int i = 0; i < 4; ++i) z[i] = __builtin_amdgcn_fmed3f(z[i], -448.0f, 448.0f);
            int b = __builtin_amdgcn_cvt_pk_fp8_f32(z[0], z[1], 0, false); b = __builtin_amdgcn_cvt_pk_fp8_f32(z[2], z[3], b, true);
            ((unsigned*)o8row)[64 * j + lane] = (unsigned)b; } }
}
__device__ __forceinline__ void cvt_chunk(const float* src, bf16_t* dst, size_t chunk, int lane) {
    const f32x4* s = (const f32x4*)(src + chunk * 512) + lane * 2; const f32x4 a = s[0], b = s[1];
    u32x4 w; w.x = pk2(a[0], a[1]); w.y = pk2(a[2], a[3]); w.z = pk2(b[0], b[1]); w.w = pk2(b[2], b[3]);
    *((u32x4*)(dst + chunk * 512) + lane) = w;
}

__device__ __forceinline__ void row_to_fp8(const float* src, unsigned char* T8, float* scl, int e, int lane, const float* gc = nullptr) {
    const f32x4* s0 = (const f32x4*)(src + (size_t)e * 2048 + 16 * lane); const f32x4* s1 = s0 + 256;
    f32x4 v[8]; float m = 0.f;
#pragma unroll
    for (int i = 0; i < 4; ++i) { v[i] = s0[i]; v[4 + i] = s1[i]; }
    if (gc) { const f32x4* g0 = (const f32x4*)(gc + 16 * lane);
#pragma unroll
        for (int i = 0; i < 4; ++i) { v[i] = v[i] * g0[i]; v[4 + i] = v[4 + i] * g0[256 + i]; } }
#pragma unroll
    for (int i = 0; i < 8; ++i) m = fmaxf(fmaxf(m, fmaxf(fabsf(v[i][0]), fabsf(v[i][1]))), fmaxf(fabsf(v[i][2]), fabsf(v[i][3])));
    m = wave_max(m); const float sc = m > 0.f ? 448.0f / m : 1.0f;
#pragma unroll
    for (int hf = 0; hf < 2; ++hf) { u32x4 w;
#pragma unroll
        for (int i = 0; i < 4; ++i) { const f32x4 x = v[hf * 4 + i] * sc; int t = __builtin_amdgcn_cvt_pk_fp8_f32(x[0], x[1], 0, false); t = __builtin_amdgcn_cvt_pk_fp8_f32(x[2], x[3], t, true); w[i] = (unsigned)t; }
        *(u32x4*)(T8 + (size_t)(hf * 8 + (lane >> 3)) * ((size_t)16384 * 128) + (size_t)e * 128 + (lane & 7) * 16) = w; }
    if (lane == 0) scl[e] = m > 0.f ? m * (1.0f / 448.0f) : 1.0f;
}
__device__ __forceinline__ void row_fp4_load(const float* src, int e, int lane, f32x4 (&v)[8]) {
    const f32x4* s0 = (const f32x4*)(src + (size_t)e * 2048) + lane;
#pragma unroll
    for (int i = 0; i < 8; ++i) v[i] = __builtin_nontemporal_load(s0 + 64 * i);
}
__device__ __forceinline__ void row_fp4_store(f32x4 (&v)[8], unsigned char* T4, float* scl, int e, int lane, const float* gc = nullptr) {
    float m = 0.f;
    if (gc) { const f32x4* g0 = (const f32x4*)gc + lane;
#pragma unroll
        for (int i = 0; i < 8; ++i) v[i] = v[i] * g0[64 * i]; }
#pragma unroll
    for (int i = 0; i < 8; ++i) m = fmaxf(fmaxf(m, fmaxf(fabsf(v[i][0]), fabsf(v[i][1]))), fmaxf(fabsf(v[i][2]), fabsf(v[i][3])));
    m = wave_max(m); const float sc = m > 0.f ? 6.0f / m : 1.0f;
#pragma unroll
    for (int i = 0; i < 8; ++i) { unsigned acc = 0u;
        const f32x4 x0 = v[i] * sc;
        acc = __builtin_amdgcn_cvt_scalef32_pk_fp4_f32(acc, x0[0], x0[1], 1.0f, 0); acc = __builtin_amdgcn_cvt_scalef32_pk_fp4_f32(acc, x0[2], x0[3], 1.0f, 1);
        *(unsigned short*)(T4 + (size_t)i * ((size_t)16384 * 128) + (size_t)e * 128 + lane * 2) = (unsigned short)acc; }
    if (lane == 0) scl[e] = m > 0.f ? m * (1.0f / 6.0f) : 1.0f;
}
__device__ __forceinline__ bf16x8 fp4x8_bf16(unsigned d) {
    typedef __bf16 bf16x2_t __attribute__((ext_vector_type(2)));
    u32x4 w; w.x = __builtin_bit_cast(unsigned, __builtin_amdgcn_cvt_scalef32_pk_bf16_fp4(d, 1.0f, 0)); w.y = __builtin_bit_cast(unsigned, __builtin_amdgcn_cvt_scalef32_pk_bf16_fp4(d, 1.0f, 1));
    w.z = __builtin_bit_cast(unsigned, __builtin_amdgcn_cvt_scalef32_pk_bf16_fp4(d, 1.0f, 2)); w.w = __builtin_bit_cast(unsigned, __builtin_amdgcn_cvt_scalef32_pk_bf16_fp4(d, 1.0f, 3));
    return __builtin_bit_cast(bf16x8, w);
}
__device__ __forceinline__ bf16x8 fp8x8_bf16(unsigned d0, unsigned d1) {
    const f32x2 a = __builtin_amdgcn_cvt_pk_f32_fp8((int)d0, false), b = __builtin_amdgcn_cvt_pk_f32_fp8((int)d0, true), c = __builtin_amdgcn_cvt_pk_f32_fp8((int)d1, false), d = __builtin_amdgcn_cvt_pk_f32_fp8((int)d1, true);
    u32x4 w; w.x = cvt_pk_bf16(a.x, a.y); w.y = cvt_pk_bf16(b.x, b.y); w.z = cvt_pk_bf16(c.x, c.y); w.w = cvt_pk_bf16(d.x, d.y);
    return __builtin_bit_cast(bf16x8, w);
}

__device__ __forceinline__ int t5_bucket(int n) {
    if (n < 16) return n;
    int b = 16;
    b += (n >= 19); b += (n >= 21); b += (n >= 24); b += (n >= 27); b += (n >= 31); b += (n >= 35); b += (n >= 40); b += (n >= 46);
    b += (n >= 52); b += (n >= 59); b += (n >= 67); b += (n >= 77); b += (n >= 87); b += (n >= 99); b += (n >= 113);
    return b;
}

__device__ __forceinline__ int fresh_lane() { unsigned l; asm volatile("v_mbcnt_lo_u32_b32 %0, -1, 0\n\tv_mbcnt_hi_u32_b32 %0, -1, %0" : "=v"(l)); return (int)l; }
__device__ __forceinline__ void glds16(const void* gsrc, unsigned lds_dst) { unsigned keep;
    asm volatile("s_mov_b32 %0, m0\n\ts_mov_b32 m0, %2\n\ts_nop 0\n\tglobal_load_lds_dwordx4 %1, off\n\ts_mov_b32 m0, %0" : "=&s"(keep) : "v"(gsrc), "s"(lds_dst) : "memory"); }
__device__ __forceinline__ int f2s(float f) { int s = __builtin_bit_cast(int, f); return s ^ ((s >> 31) & 0x7fffffff); }
__device__ __forceinline__ float s2f(int s) { return __builtin_bit_cast(float, s ^ ((s >> 31) & 0x7fffffff)); }
#define INS16(L, vv) do { int _v = (vv); _Pragma("unroll") for (int _j = 0; _j < 16; ++_j) { const int _h = max(L[_j], _v); _v = min(L[_j], _v); L[_j] = _h; } } while (0)

#define CEX(L, i_, j_) do { const int _a = max(L[i_], L[j_]), _b = min(L[i_], L[j_]); L[i_] = _a; L[j_] = _b; } while (0)
__device__ __forceinline__ void bitonic_sort16(int (&L)[16]) {
#pragma unroll
    for (int k = 2; k <= 16; k <<= 1)
#pragma unroll
        for (int j = k >> 1; j >= 1; j >>= 1)
#pragma unroll
            for (int i = 0; i < 16; ++i) { const int l = i ^ j; if (l > i) { if ((i & k) == 0) CEX(L, i, l); else CEX(L, l, i); } }
}
__device__ __forceinline__ void merge_top16(int (&L)[16], const int (&N)[16]) {
#pragma unroll
    for (int i = 0; i < 16; ++i) L[i] = max(L[i], N[15 - i]);
#pragma unroll
    for (int d = 8; d >= 1; d >>= 1)
#pragma unroll
        for (int i = 0; i < 16; ++i) if ((i & d) == 0) CEX(L, i, i + d);
}
__device__ __forceinline__ void peer_top16(const bf16_t* qp, const bf16_t* kp, int hh, int (&L)[16]) {
#pragma unroll
    for (int i = 0; i < 16; ++i) L[i] = (int)0x80000000;
#pragma unroll 1
    for (int kt = 0; kt < 4; ++kt) {
        f32x16 sc = (f32x16){};
#pragma unroll
        for (int k0 = 0; k0 < 8; ++k0) { const bf16x8 af = *(const bf16x8*)(kp + (size_t)kt * 32 * 128 + 16 * k0); const bf16x8 bq = *(const bf16x8*)(qp + 16 * k0); sc = __builtin_amdgcn_mfma_f32_32x32x16_bf16(af, bq, sc, 0, 0, 0); }
        const int kbase = 32 * kt + 4 * hh;
        int N[16];
#pragma unroll
        for (int r = 0; r < 16; ++r) N[r] = (f2s(sc[r]) & ~0x7f) | (kbase + (r & 3) + 8 * (r >> 2));
        bitonic_sort16(N);
        merge_top16(L, N);
    }
    int m[16];
#pragma unroll
    for (int i = 0; i < 16; ++i) { auto rr = __builtin_amdgcn_permlane32_swap((unsigned)L[i], (unsigned)L[i], false, false); m[i] = hh ? (int)rr[0] : (int)rr[1]; }
    merge_top16(L, m);
}

template <int VAR3, int VAR10 = 0> __global__ void __launch_bounds__(512, 2) fwd_t(Args args) {
    extern __shared__ __attribute__((aligned(16))) unsigned char lds_raw[];
    LAS unsigned char* lds = (LAS unsigned char*)lds_raw;
    volatile LAS unsigned* MISC = (volatile LAS unsigned*)(lds + MISC_OFF);
    const int tid = threadIdx.x, lane = tid & 63, wave = __builtin_amdgcn_readfirstlane(tid >> 6);
    const int G = gridDim.x, bx = blockIdx.x, vcu = (G % 8 == 0) ? (bx % 8) * (G / 8) + bx / 8 : bx;
    unsigned char* ws = args.ws;
    unsigned* ctl = (unsigned*)(ws + WS_CTL);
    for (int u = tid; u < (LDS_BYTES - RING_BYTES) / 4; u += 512) ((LAS unsigned*)(lds + RING_BYTES))[u] = 0u;
    __syncthreads();
#if MK_SPLIT
#define GRID_BAR() do { } while (0)
#else
    XcdBarrier bar = xcd_barrier_post(ctl + CW_BAR, MISC + 8);
#define GRID_BAR() xcd_barrier(bar)
#endif
    const int lo = args.ph_lo, hi = args.ph_hi;
#ifdef ONLY_PHASE
#define IN(k) ((k) == ONLY_PHASE)
#else
#define IN(k) ((VAR10 == 0 || (k) == 10) && (VAR3 == 0 || (k) == 3) && lo <= (k) && (k) < hi)
#endif
#define SEAM(k) do { if (IN(k) && IN((k) + 1)) GRID_BAR(); } while (0)

    bf16_t* WIN = (bf16_t*)(ws + WS_WIN); bf16_t* WOUT = (bf16_t*)(ws + WS_WOUT); bf16_t* WCQ = (bf16_t*)(ws + WS_WCQ); bf16_t* WCKV = (bf16_t*)(ws + WS_WCKV);
    bf16_t* WCO = (bf16_t*)(ws + WS_WCO); bf16_t* WPQ = (bf16_t*)(ws + WS_WPQ); bf16_t* KEYS = (bf16_t*)(ws + WS_KEYS); bf16_t* SGUW = (bf16_t*)(ws + WS_SGUW);
    float* KGQG = (float*)(ws + WS_MISC);
    bf16_t* MEMN = (bf16_t*)(ws + WS_MEMN); bf16_t* KC = (bf16_t*)(ws + WS_KC); bf16_t* VCT = (bf16_t*)(ws + WS_VCT); float* LPART = (float*)(ws + WS_LPART);
    bf16_t* XN = (bf16_t*)(ws + WS_XN); bf16_t* Z = (bf16_t*)(ws + WS_Z); bf16_t* QC = (bf16_t*)(ws + WS_QC); bf16_t* PC = (bf16_t*)(ws + WS_PC); bf16_t* QP = (bf16_t*)(ws + WS_QP);
    bf16_t* VT = (bf16_t*)(ws + WS_VT); bf16_t* MIX = (bf16_t*)(ws + WS_MIX);
    u64* SSQ1 = (u64*)(ws + CB_SSQ1); u64* SSQ2 = (u64*)(ws + CB_SSQ2); u64* SSQK = (u64*)(ws + CB_SSQK); u64* SSQQ = (u64*)(ws + CB_SSQQ);
#if MK_SPLIT
    const bool dup = args.dup != 0;
    u64* SSQ1w = dup ? (u64*)(ws + WS_MISC + 65536) : SSQ1; u64* SSQ2w = dup ? (u64*)(ws + WS_MISC + 65536) : SSQ2; u64* SSQKw = dup ? (u64*)(ws + WS_MISC + 65536) : SSQK; u64* SSQQw = dup ? (u64*)(ws + WS_MISC + 65536) : SSQQ;
    const float dupscale = dup ? 0.f : 1.f; bf16_t* QKNW = dup ? XN : Z + 2048; const int qknld = dup ? 2048 : 4096;
#else
    u64* SSQ1w = SSQ1; u64* SSQ2w = SSQ2; u64* SSQKw = SSQK; u64* SSQQw = SSQQ; const float dupscale = 1.f; bf16_t* QKNW = Z + 2048; const int qknld = 4096;
#endif
#define P10SCALE ((VAR10 != 0) ? 0.0f : 1.0f)
#define P10STORE (VAR10 == 0)
    const int gw = vcu * 8 + wave, NGW = G * 8;

    if (IN(0)) {
        LAS float* scr = (LAS float*)(lds + wave * 16384);
        constexpr int I_IN = 32 * (5120 / 32), I_SQ = 32 * (2048 / 32), I_KV = 32 * (4096 / 32);
        constexpr int NIT = I_IN + 4 * I_SQ + I_KV;
        for (int it = gw; it < NIT; it += NGW) {
            int r = it;
            if (r < I_IN) { if (r % (5120 / 32) < 2048 / 32) p0_transpose_item<false, true>(args.in[I_WIN], 2048, 5120, WIN, scr, r, lane);
                            else p0_transpose_item<false>(args.in[I_WIN], 2048, 5120, WIN, scr, r, lane); continue; } r -= I_IN;
            if (r < I_SQ) { p0_transpose_item<false>(args.in[I_WOUT], 2048, 2048, WOUT, scr, r, lane); continue; } r -= I_SQ;
            if (r < I_SQ) { p0_transpose_item<true, true>(args.in[I_WCQ], 2048, 2048, WCQ, scr, r, lane, args.in[I_NCG]); continue; } r -= I_SQ;
            if (r < I_KV) { p0_transpose_item<false>(args.in[I_WCKV], 2048, 4096, WCKV, scr, r, lane); continue; } r -= I_KV;
            if (r < I_SQ) { p0_transpose_item<false, true>(args.in[I_WCO], 2048, 2048, WCO, scr, r, lane); continue; } r -= I_SQ;
            p0_transpose_item<true>(args.in[I_PWQ], 2048, 2048, WPQ, scr, r, lane, args.in[I_NFG]);
        }
        for (int m = gw; m < T; m += NGW) rms_row_to_bf16(args.in[I_X] + (size_t)m * D, args.in[I_NMIXG], XN + (size_t)m * D, lane, ws + WS_MIX + (size_t)m * D);
        for (int m = gw; m < MROWS; m += NGW) rms_row_to_bf16(args.in[I_MEM] + (size_t)m * D, args.in[I_NMG], MEMN + (size_t)m * D, lane);
        for (int c = gw; c < 262144 / 512; c += NGW) cvt_chunk(args.in[I_PKEYS], KEYS, c, lane);
        { f32x4 ua[8], va[8];
          if (gw < 16384) { row_fp4_load(args.in[I_PU], gw, lane, ua); row_fp4_load(args.in[I_PV], gw, lane, va); }
          for (int e = gw; e < 16384; e += NGW) { f32x4 ub[8], vb[8]; const int en = (e + NGW < 16384) ? e + NGW : e;
              row_fp4_load(args.in[I_PU], en, lane, ub); row_fp4_load(args.in[I_PV], en, lane, vb);
              row_fp4_store(ua, ws + WS_U8, (float*)(ws + WS_USC), e, lane, args.in[I_NFG]); row_fp4_store(va, ws + WS_V8, (float*)(ws + WS_VSC), e, lane);
#pragma unroll
              for (int i = 0; i < 8; ++i) { ua[i] = ub[i]; va[i] = vb[i]; } } }
        for (int i = gw * 64 + lane; i < 8 * 128 * 128; i += NGW * 64) { const int p = (i >> 7) & 127, q = i & 127; SGUW[i] = (bf16_t)f2bf(q <= p ? args.in[I_SGUW][i] : 0.f); }
        if (bx == 0) { const float v = args.in[I_CKG][tid] * args.in[I_CQG][tid]; KGQG[tid] = v; }
    }
    SEAM(0);

    if (IN(1)) {
        { pg8::Gemm g{D / 2, D / 2, D / 2}; pg8::PlainOrder S; S.init(ws + WS_MIX, WIN, D / 2, D / 2, T, 2048, G, bx);
          pg8::EpiB<true, false, false, false> E{Z, 4096, 8, nullptr, 0, nullptr, 0.f, nullptr, 0, 1, 1.0f / (A8_SCALE * W8_SCALE)};
          pg8::gemm_phase<true>(lds, g, S, E); }
        { pg8::Gemm g{D, D, D}; pg8::PlainOrder S; S.init(XN, WIN + (size_t)2048 * D, D, D, T, 2048, G, bx);
          pg8::EpiB<false, false, false, false> E{Z + 2048, 4096, 0, nullptr, 0, nullptr, 0.f, nullptr, 0, 1};
          pg8::gemm_phase(lds, g, S, E); }
        { pg8::Gemm g{D, D, D}; pg8::PlainOrder S; S.init(WIN + (size_t)4096 * D, XN, D, D, 1024, T, G, bx);
          pg8::EpiB<false, false, false, false> E{VT, T, 0, nullptr, 0, nullptr, 0.f, nullptr, 0, 1};
          pg8::gemm_phase(lds, g, S, E); }
    }
    SEAM(1);

    if (IN(2)) {
        constexpr int VROW = 136;
        LAS bf16_t* vnT = (LAS bf16_t*)lds;
        const float* sgu_g = args.in[I_SGUNG]; const float* sgu_b = args.in[I_SGUB];
        const bool kvsplit = (G == 256); const bool kvcu = kvsplit && vcu < 64;
        const int sv = kvsplit ? vcu - 64 : vcu, SG = kvsplit ? G - 64 : G;
        if (kvcu || !kvsplit) { pg8::Gemm g{D, D, D};
          pg8::PairOrder S{(const char*)MEMN, (const char*)WCKV, (const char*)(WCKV + (size_t)2048 * D), (const char*)MEMN, D, D, MROWS / 256, 2048 / 256, 2048 / 256, MROWS / 256, kvsplit ? 64 : G, vcu};
          pg8::EpiKV E{KC, VCT, KGQG, SSQKw};
          pg8::gemm_phase(lds, g, S, E); }
        if (!kvcu)
        for (int uidx = sv; uidx < 1024; uidx += SG) {
            const int b = uidx >> 8, n = (uidx >> 3) & 31, h = uidx & 7; const size_t t0 = (size_t)b * SEQ + n * 128;
            __syncthreads();
            { const int p = tid >> 2, part = tid & 3; const bf16_t* vp = Z + (t0 + p) * 4096 + 1024 + h * 128 + part * 32;
              u32x4 raw[4]; float f[32]; float s = 0.f;
#pragma unroll
              for (int i = 0; i < 4; ++i) raw[i] = *(const u32x4*)(vp + i * 8);
#pragma unroll
              for (int i = 0; i < 4; ++i)
#pragma unroll
                  for (int e = 0; e < 4; ++e) { f[i * 8 + 2 * e] = bflo(raw[i][e]); f[i * 8 + 2 * e + 1] = bfhi(raw[i][e]); }
#pragma unroll
              for (int i = 0; i < 32; ++i) s += f[i] * f[i];
              s += __shfl_xor(s, 1); s += __shfl_xor(s, 2);
              const float rstd = 1.0f / sqrtf(s * (1.0f / 128.0f) + EPS);
#pragma unroll
              for (int i = 0; i < 32; ++i) { const int c = part * 32 + i; vnT[c * VROW + p] = (bf16_t)f2bf(f[i] * rstd * sgu_g[h * 128 + c]); }
            }
            __syncthreads();
            { const int wp = wave & 3, wcc = wave >> 2, j = lane & 31, hh = lane >> 5;
              f32x16 acc[2]; acc[0] = (f32x16){}; acc[1] = (f32x16){};
              const bf16_t* wrow = SGUW + ((size_t)h * 128 + 32 * wp + j) * 128 + 8 * hh;
              for (int ks = 0; ks <= 2 * wp + 1; ++ks) {
                  const bf16x8 bfr = *(const bf16x8*)(wrow + 16 * ks);
#pragma unroll
                  for (int ct = 0; ct < 2; ++ct) { const bf16x8 afr = *(const LAS bf16x8*)(vnT + (64 * wcc + 32 * ct + j) * VROW + 16 * ks + 8 * hh);
                      acc[ct] = __builtin_amdgcn_mfma_f32_32x32x16_bf16(afr, bfr, acc[ct], 0, 0, 0); }
              }
              const int p = 32 * wp + j; const float bs = sgu_b[h * 128 + p]; const size_t tok = t0 + p;
#pragma unroll
              for (int ct = 0; ct < 2; ++ct)
#pragma unroll
                  for (int g4 = 0; g4 < 4; ++g4) { const int c = 64 * wcc + 32 * ct + 8 * g4 + 4 * hh;
                      const u32x2 uu = *(const u32x2*)(Z + tok * 4096 + h * 128 + c);
                      const float o0 = bflo(uu.x) * (acc[ct][4 * g4 + 0] + bs), o1 = bfhi(uu.x) * (acc[ct][4 * g4 + 1] + bs), o2 = bflo(uu.y) * (acc[ct][4 * g4 + 2] + bs), o3 = bfhi(uu.y) * (acc[ct][4 * g4 + 3] + bs);
                      u32x2 w; w.x = pk2(o0, o1); w.y = pk2(o2, o3); *(u32x2*)(MIX + tok * D + h * 128 + c) = w; }
            }
        }
        { const float* qg = args.in[I_QNG]; const float* kg = args.in[I_KNG]; const int d0 = (lane & 7) * 8;
          float gq[8], gk[8];
#pragma unroll
          for (int e = 0; e < 8; ++e) { gq[e] = qg[d0 + e] * (0.125f * LOG2E); gk[e] = kg[d0 + e]; }
          if (!kvcu)
          for (int t = sv * 8 + wave; t < T; t += SG * 8) {
#pragma unroll
              for (int i = 0; i < 4; ++i) { const int vi = 8 * i + (lane >> 3); bf16_t* p = Z + (size_t)t * 4096 + 2048 + vi * 64 + d0;
                  const u32x4 raw = *(const u32x4*)p; float f[8];
#pragma unroll
                  for (int e = 0; e < 4; ++e) { f[2 * e] = bflo(raw[e]); f[2 * e + 1] = bfhi(raw[e]); }
                  float s = 0.f;
#pragma unroll
                  for (int e = 0; e < 8; ++e) s += f[e] * f[e];
                  s += __shfl_xor(s, 1); s += __shfl_xor(s, 2); s += __shfl_xor(s, 4);
                  const float rstd = 1.0f / sqrtf(s * (1.0f / 64.0f) + EPS);
                  u32x4 w;
#pragma unroll
                  for (int e = 0; e < 4; ++e) { const float g0 = (i < 2) ? gq[2 * e] : gk[2 * e], g1 = (i < 2) ? gq[2 * e + 1] : gk[2 * e + 1]; w[e] = pk2(f[2 * e] * rstd * g0, f[2 * e + 1] * rstd * g1); }
                  *(u32x4*)(QKNW + (size_t)t * qknld + vi * 64 + d0) = w; }
          }
        }
    }
    SEAM(2);

    if (IN(3)) {
        constexpr int STG = 32768;
        constexpr int var3 = VAR3; bf16_t* AOUT = (VAR3 != 0) ? XN : MIX;
        LAS float* tab = (LAS float*)(lds + RING_BYTES + 1024);
        const float* relb = args.in[I_RELB];
        const int j = lane & 31, hh = lane >> 5, w = wave, g = w & 3, c = w >> 2;
        const int pi = (j & ~12) | ((j & 4) << 1) | ((j & 8) >> 1);
        int koff[4], voff[4];
#pragma unroll
        for (int d0 = 0; d0 < 4; ++d0) { koff[d0] = c * 8192 + pi * 128 + (((2 * d0 + hh) ^ ((pi >> 1) & 7)) << 4); voff[d0] = 16384 + j * 128 + (((2 * d0 + hh) ^ ((j >> 1) & 7)) << 4); }
        const int bh = vcu >> 3, sidx = vcu & 7, b = bh >> 3, h = bh & 7;
        const unsigned lds0 = (unsigned)(size_t)lds;
        if (bh < 32) {
        __syncthreads();
        if (tid < 128) tab[tid] = relb[t5_bucket(tid) * 8 + h] * LOG2E;
        if (wave == 2) {
            const float a1 = wave_sum(args.in[I_LQ1][lane] * args.in[I_LK1][lane]), a2 = wave_sum(args.in[I_LQ2][lane] * args.in[I_LK2][lane]);
            const float gqm = wave_max(fabsf(args.in[I_QNG][lane])), gkm = wave_max(fabsf(args.in[I_KNG][lane]));
            const float bmax = wave_max(lane < 32 ? relb[lane * 8 + h] : -1e30f);
            const float M2 = LOG2E * (8.0f * gqm * gkm + bmax);
            const float B31 = relb[31 * 8 + h] * LOG2E; const bool needshift = (M2 - B31) > 60.0f; const float SH = needshift ? M2 : B31;
            if (lane == 0) { tab[128] = -SH; tab[129] = B31 - SH; tab[130] = expf(a1) - expf(a2) + 0.2f; tab[131] = needshift ? 1.0f : 0.0f; }
        }
        __syncthreads();
        const float c_near = tab[128], c_far = tab[129], lam = tab[130]; const bool needshift = tab[131] != 0.f;
        const size_t tokbase = (size_t)b * SEQ;
        for (int ui = 0; ui < 4; ++ui) {
            const int qb = ui == 0 ? 31 - sidx : (ui == 1 ? 16 + sidx : (ui == 2 ? 15 - sidx : sidx));
            const int q0 = qb * 128, NT = (q0 + 128) / 64, my_last = qb * 2 + (g >> 1);
            const int qpos = q0 + 32 * g + j;
            bf16x8 Q[4];
            { const bf16_t* qrow = Z + (tokbase + qpos) * 4096 + 2048 + h * 128 + c * 64 + hh * 8;
#pragma unroll
              for (int d0 = 0; d0 < 4; ++d0) Q[d0] = *(const bf16x8*)(qrow + d0 * 16); }
            const int krow = 8 * w + (lane >> 3), kgr = (lane & 7) ^ ((krow >> 1) & 7);
            const int vd0 = 16 * w + (lane >> 3), vd1 = vd0 + 8;
            const unsigned kvo = (unsigned)(krow * 4096 + kgr * 8) * 2u;
            const unsigned vvo0 = (unsigned)(vd0 * T + ((lane & 7) ^ ((vd0 >> 1) & 7)) * 8) * 2u, vvo1 = (unsigned)(vd1 * T + ((lane & 7) ^ ((vd1 >> 1) & 7)) * 8) * 2u;
            const bf16_t* const kb0 = Z + tokbase * 4096 + 3072 + h * 128; const bf16_t* const vb0 = VT + (size_t)(h * 128) * T + tokbase;
#define DA_ISSUE(t_, st_) do { const bf16_t* kb_ = kb0 + (size_t)(t_) * 64 * 4096; const bf16_t* vb_ = vb0 + (t_) * 64; \
            const unsigned sb_ = (unsigned)__builtin_amdgcn_readfirstlane((int)(lds0 + (unsigned)(st_) * STG + (unsigned)w * 1024u)); \
            const unsigned sv_ = (unsigned)__builtin_amdgcn_readfirstlane((int)(lds0 + (unsigned)(st_) * STG + 16384u + (unsigned)w * 2048u)); \
            glds16s((const void*)kb_, kvo, sb_); glds16s((const void*)(kb_ + 64), kvo, sb_ + 8192u); \
            glds16s((const void*)vb_, vvo0, sv_); glds16s((const void*)vb_, vvo1, sv_ + 1024u); } while (0)
            f32x16 O[4];
#pragma unroll
            for (int dt = 0; dt < 4; ++dt) O[dt] = (f32x16){};
            float lsum = 0.f;
            bf16x8 P[4];
#pragma unroll
            for (int i = 0; i < 4; ++i) P[i] = (bf16x8){0, 0, 0, 0, 0, 0, 0, 0};
#define DA_LDK(kb_) do { _Pragma("unroll") for (int d0 = 0; d0 < 4; ++d0) { kf[2 * d0] = *(const LAS bf16x8*)((kb_) + koff[d0]); kf[2 * d0 + 1] = *(const LAS bf16x8*)((kb_) + 4096 + koff[d0]); } } while (0)
#define DA_LDVG(BUF, kb_, ks_) do { _Pragma("unroll") for (int dt = 0; dt < 4; ++dt) BUF[dt] = *(const LAS bf16x8*)((kb_) + dt * 4096 + voff[ks_]); } while (0)
#define DA_S(ci_) do { if (needshift) { _Pragma("unroll") for (int r = 0; r < 16; ++r) S0[r] = (ci_); \
                    S1 = __builtin_amdgcn_mfma_f32_32x32x16_bf16(kf[1], Q[0], S0, 0, 0, 0); S0 = __builtin_amdgcn_mfma_f32_32x32x16_bf16(kf[0], Q[0], S0, 0, 0, 0); }     \
                else { S0 = __builtin_amdgcn_mfma_f32_32x32x16_bf16(kf[0], Q[0], (f32x16){}, 0, 0, 0); S1 = __builtin_amdgcn_mfma_f32_32x32x16_bf16(kf[1], Q[0], (f32x16){}, 0, 0, 0); } \
                _Pragma("unroll") for (int d0 = 1; d0 < 4; ++d0) { S0 = __builtin_amdgcn_mfma_f32_32x32x16_bf16(kf[2 * d0], Q[d0], S0, 0, 0, 0); S1 = __builtin_amdgcn_mfma_f32_32x32x16_bf16(kf[2 * d0 + 1], Q[d0], S1, 0, 0, 0); } } while (0)
#define DA_BIAS(key0_) do { _Pragma("unroll") for (int r = 0; r < 16; ++r) { const int kk = (key0_) + 16 * (r >> 3) + 8 * hh + (r & 7); const int d_0 = qpos - kk, d_1 = d_0 - 32; \
                    S0[r] = d_0 < 0 ? -INFINITY : S0[r] + (tab[d_0 > 127 ? 127 : (d_0 < 0 ? 0 : d_0)] + dnear); \
                    S1[r] = d_1 < 0 ? -INFINITY : S1[r] + (tab[d_1 > 127 ? 127 : (d_1 < 0 ? 0 : d_1)] + dnear); } } while (0)
#define DA_SX(n_) (((n_) < 16) ? S0[(n_) & 15] : S1[(n_) & 15])
#define DA_EXP2(i_) do { const float e0_ = __builtin_amdgcn_exp2f(DA_SX(2 * (i_))), e1_ = __builtin_amdgcn_exp2f(DA_SX(2 * (i_) + 1)); lsum += e0_; lsum += e1_; PW[i_] = __builtin_bit_cast(unsigned, __builtin_convertvector((f32x2){e0_, e1_}, da_bf16x2_t)); } while (0)
#define DA_PACK() do { P[0] = __builtin_bit_cast(bf16x8, (u32x4){PW[0], PW[1], PW[2], PW[3]}); P[1] = __builtin_bit_cast(bf16x8, (u32x4){PW[4], PW[5], PW[6], PW[7]}); \
                P[2] = __builtin_bit_cast(bf16x8, (u32x4){PW[8], PW[9], PW[10], PW[11]}); P[3] = __builtin_bit_cast(bf16x8, (u32x4){PW[12], PW[13], PW[14], PW[15]}); } while (0)
#define DA_PVX(kb_, SM) do { bf16x8 va[4], vb[4]; DA_LDVG(va, kb_, 0); \
                _Pragma("unroll") for (int k = 0; k < 4; ++k) { \
                    if (k == 0) DA_LDVG(vb, kb_, 1); else if (k == 1) DA_LDVG(va, kb_, 2); else if (k == 2) DA_LDVG(vb, kb_, 3); \
                    _Pragma("unroll") for (int dt = 0; dt < 4; ++dt) { \
                        O[dt] = __builtin_amdgcn_mfma_f32_32x32x16_bf16((k & 1) ? vb[dt] : va[dt], P[k], O[dt], 0, 0, 0); \
                        if (SM) DA_EXP2(4 * k + dt); \
                        __builtin_amdgcn_sched_barrier(0); } } } while (0)
#define DA_SYNC(t_) do { if ((t_) + 2 < NT) asm volatile("s_waitcnt vmcnt(4)" ::: "memory"); else asm volatile("s_waitcnt vmcnt(0)" ::: "memory");     \
                __builtin_amdgcn_s_barrier();                               \
                asm volatile("" ::: "memory"); \
                if ((t_) + 3 < NT) DA_ISSUE((t_) + 3, ((t_) + 3) & 3); } while (0)
            DA_ISSUE(0, 0); DA_ISSUE(1, 1);
            if (2 < NT) DA_ISSUE(2, 2);
            typedef __bf16 da_bf16x2_t __attribute__((ext_vector_type(2)));
            unsigned PW[16];
            const float dnear = c_near - c_far;
            { f32x16 S0, S1; bf16x8 kf[8];
              DA_SYNC(0);
              { const bool far = (63 + 113 <= q0 + 32 * g);
                DA_LDK(lds); __builtin_amdgcn_sched_barrier(0);
                DA_S(c_far);
                if (!far) DA_BIAS(0);
#pragma unroll
                for (int i = 0; i < 16; ++i) DA_EXP2(i);
                DA_PACK(); }
              for (int t = 0; t < NT; ++t) {
                  if (t > 0) DA_SYNC(t);
                  if (t <= my_last) {
                      const LAS unsigned char* kbv = lds + (t & 3) * STG;
                      if (t + 1 <= my_last) {
                          const LAS unsigned char* kbk = lds + ((t + 1) & 3) * STG; const int key0 = (t + 1) * 64;
                          const bool far = (key0 + 63 + 113 <= q0 + 32 * g);
                          DA_LDK(kbk); __builtin_amdgcn_sched_barrier(0);
                          DA_S(c_far);
                          if (!far) DA_BIAS(key0);
                          __builtin_amdgcn_sched_barrier(0);
                          DA_PVX(kbv, true);
                          DA_PACK();
                      } else { DA_PVX(kbv, false); }
                  }
              }
            }
#undef DA_SYNC
#undef DA_LDK
#undef DA_LDVG
#undef DA_S
#undef DA_BIAS
#undef DA_SX
#undef DA_EXP2
#undef DA_PACK
#undef DA_PVX
            { auto r1 = __builtin_amdgcn_permlane32_swap(__float_as_uint(lsum), __float_as_uint(lsum), false, false); lsum = __uint_as_float(r1[0]) + __uint_as_float(r1[1]); }
            __syncthreads();
            LAS float* xch = (LAS float*)(lds + g * 16384) + lane;
            if (c == 1) { const float i2 = lam / lsum;
#pragma unroll
                for (int dt = 0; dt < 4; ++dt)
#pragma unroll
                    for (int r = 0; r < 16; ++r) xch[(dt * 16 + r) * 64] = O[dt][r] * i2; }
            __syncthreads();
            if (c == 0) { const float i1 = 1.0f / lsum; float ss = 0.f;
#pragma unroll
                for (int dt = 0; dt < 4; ++dt)
#pragma unroll
                    for (int r = 0; r < 16; ++r) { const float o = O[dt][r] * i1 - xch[(dt * 16 + r) * 64]; O[dt][r] = o; ss += o * o; }
                auto r3 = __builtin_amdgcn_permlane32_swap(__float_as_uint(ss), __float_as_uint(ss), false, false); ss = __uint_as_float(r3[0]) + __uint_as_float(r3[1]);
                const float rstd = 0.8f / sqrtf(ss * (1.0f / 128.0f) + EPS);
                const float* sg = args.in[I_SUBG]; bf16_t* orow = AOUT + (tokbase + qpos) * D + 1024 + h * 128;
#pragma unroll
                for (int dt = 0; dt < 4; ++dt)
#pragma unroll
                    for (int g4 = 0; g4 < 4; ++g4) { const int d = 32 * dt + 8 * g4 + 4 * hh; const f32x4 gg = *(const f32x4*)(sg + d);
                        u32x2 wv; wv.x = pk2(O[dt][4 * g4] * rstd * gg[0], O[dt][4 * g4 + 1] * rstd * gg[1]); wv.y = pk2(O[dt][4 * g4 + 2] * rstd * gg[2], O[dt][4 * g4 + 3] * rstd * gg[3]);
                        *(u32x2*)(orow + d) = wv; }
            }
            __syncthreads();
        }
        }
#undef DA_ISSUE
    }
    SEAM(3);

    if (IN(4)) {
        pg8::Gemm g{D, D, D}; pg8::PlainOrder S; S.init(MIX, WOUT, D, D, T, D, G, bx);
        pg8::EpiH<true> E{args.in[I_X], XN, SSQ1w, 1.f, ws + WS_H8};
        pg8::gemm_phase(lds, g, S, E);
    }
    SEAM(4);

    if (IN(5)) {
        pg8::Gemm g{D / 2, D / 2, D / 2}; pg8::PlainOrder S; S.init(ws + WS_H8, WCQ, D / 2, D / 2, T, D, G, bx);
        pg8::EpiB<false, false, false, true> E{QC, D, 0, nullptr, 0, nullptr, 0.f, SSQQw, 4, 2, 1.0f / (A8_SCALE * W8_SCALE)};
        pg8::gemm_phase<true>(lds, g, S, E);
    }
    SEAM(5);

    if (IN(6)) {
        __syncthreads();
        if (wave == 0) { float a = 0.f, c = 0.f;
            for (int i = lane; i < 512; i += 64) { a = fmaxf(a, fabsf(args.in[I_CQG][i])); c = fmaxf(c, fabsf(args.in[I_CKG][i])); }
            a = wave_max(a); c = wave_max(c); if (lane == 0) ((LAS float*)(lds + RING_BYTES))[16] = 22.627416998f * a * c * LOG2E; }
        __syncthreads();
        const float cshift = ((LAS float*)(lds + RING_BYTES))[16];
        pg8::Gemm g{D, D, 512};
        pg8::BatchOrder S{(const char*)QC, (const char*)KC, D, D, 16, 1, 256, G, vcu, (size_t)SEQ * D * 2, 512 * 2, (size_t)MEML * D * 2, 512 * 2};
        pg8::EpiS E{PC, SSQ1, SSQQ, SSQK, LPART, cshift};
        pg8::gemm_phase(lds, g, S, E);
    }
    SEAM(6);

    if (IN(7)) {
        pg8::Gemm g{1024, MROWS, 256};
        pg8::BatchOrder S{(const char*)PC, (const char*)VCT, 1024, MROWS, 16, 2, 512, G, vcu, (size_t)SEQ * 1024 * 2, 256 * 2, 256 * 2, (size_t)512 * MROWS * 2};
        pg8::EpiPV E{(unsigned char*)MIX, LPART};
        pg8::gemm_phase(lds, g, S, E);
    }
    SEAM(7);

    if (IN(8)) {
        pg8::Gemm g{D / 2, D / 2, D / 2}; pg8::PlainOrder S; S.init(MIX, WCO, D / 2, D / 2, T, D, G, bx);
        pg8::EpiH<false> E{XN, XN, SSQ2w, dupscale * (1.0f / (OC8_SCALE * W8_SCALE))};
        pg8::gemm_phase<true>(lds, g, S, E);
    }
    SEAM(8);

    if (IN(9)) {
        pg8::Gemm g{D, D, D}; pg8::PlainOrder S; S.init(XN, WPQ, D, D, T, D, G, bx);
        pg8::EpiB<false, false, true, false> E{QP, D, 0, nullptr, 0, SSQ2, 1.0f / 2048.0f, nullptr, 0, 1};
        pg8::gemm_phase(lds, g, S, E);
    }
    SEAM(9);

    if (IN(10)) {
        constexpr size_t SLICE = (size_t)16384 * 128;
        LAS unsigned short* PIDX = (LAS unsigned short*)lds;
        LAS float* PGT = (LAS float*)(lds + 16384);
        LAS float* AACC = (LAS float*)(lds + 49152);
        LAS unsigned char* KSEL = lds + 81920;
        const unsigned char* U8 = ws + WS_U8; const unsigned char* V8 = ws + WS_V8; const float* USC = (const float*)(ws + WS_USC); const float* VSC = (const float*)(ws + WS_VSC);
        const int j = lane & 31, hh = lane >> 5;
        const int xcc = (int)xb_xcc_id();
        for (int tb = vcu; tb < T / 64; tb += G) {
            const int tok0 = tb * 64;
            __syncthreads();
            constexpr int sub = (VAR10 == 4) ? 0 : VAR10;
            if (sub >= 2) { for (int i = tid; i < 8192; i += 512) { PIDX[i] = (unsigned short)((i * 2654435761u >> 7) & 16383u); PGT[i] = 0.f; } }
            if (sub <= 1)
            for (int task = wave; task < 16; task += 8) {
                const int tgl = task >> 3, h = task & 7; const int tokl = 32 * tgl + j; const size_t tok = (size_t)tok0 + tokl;
                int L1[16], L2[16];
                peer_top16(QP + tok * D + h * 256 + 8 * hh, KEYS + ((size_t)(h * 2) * 128 + j) * 128 + 8 * hh, hh, L1);
                peer_top16(QP + tok * D + h * 256 + 128 + 8 * hh, KEYS + ((size_t)(h * 2 + 1) * 128 + j) * 128 + 8 * hh, hh, L2);
                float a1[16], a2[16];
#pragma unroll
                for (int i = 0; i < 16; ++i) { a1[i] = s2f(L1[i] & ~0x7f); a2[i] = s2f(L2[i] & ~0x7f); }
                int C0[16], C1[16], C2[16], C3[16];
#pragma unroll
                for (int i = 0; i < 16; ++i) { C0[i] = (int)0x80000000; C1[i] = (int)0x80000000; C2[i] = (int)0x80000000; C3[i] = (int)0x80000000; }
                { int n = 0;
#pragma unroll
                  for (int i = 0; i < 16; ++i)
#pragma unroll
                      for (int jj = 0; jj < 16; ++jj) if ((i + 1) * (jj + 1) <= 16) { const int v = (f2s(a1[i] + a2[jj]) & ~0xff) | (i << 4) | jj;
                          if (n < 16) C0[n & 15] = v; else if (n < 32) C1[n & 15] = v; else if (n < 48) C2[n & 15] = v; else C3[n & 15] = v; ++n; } }
                bitonic_sort16(C0); bitonic_sort16(C1); bitonic_sort16(C2); CEX(C3, 0, 1);
                merge_top16(C0, C1); merge_top16(C2, C3); merge_top16(C0, C2);
                int (&Lf)[16] = C0;
#pragma unroll
                for (int i = 0; i < 16; ++i) { KSEL[i * 512 + tid] = (unsigned char)(L1[i] & 0x7f); KSEL[8192 + i * 512 + tid] = (unsigned char)(L2[i] & 0x7f); }
                float sc16[16]; float sum = 0.f;
                const float smax = s2f(Lf[0] & ~0xff);
#pragma unroll
                for (int k = 0; k < 16; ++k) { sc16[k] = __expf(s2f(Lf[k] & ~0xff) - smax); sum += sc16[k]; }
                const float inv = 1.0f / sum;
                if (hh == 0) {
#pragma unroll
                    for (int k = 0; k < 16; ++k) { const int code = Lf[k] & 0xff; const int e = (int)KSEL[(code >> 4) * 512 + tid] * 128 + (int)KSEL[8192 + (code & 15) * 512 + tid];
                        PIDX[tokl * 128 + h * 16 + k] = (unsigned short)e; PGT[tokl * 128 + h * 16 + k] = sc16[k] * inv; }
                }
            }
#pragma unroll
            for (int i = 0; i < 16; ++i) AACC[wave * 1024 + i * 64 + lane] = 0.f;
            __syncthreads();
            if (sub == 0 || sub == 2)
            { const int ul = fresh_lane(); const int un = ul & 15, ukq = ul >> 4, uchi = ul & 3, urho = ul >> 2;
              const bool bon = ((ukq >> 1) == ((un >> 2) & 1)), bhi = (un >> 3) != 0;
              LAS unsigned char* XS = lds + 98304 + wave * 4096;
              u32x4 bufA[16], bufB[16]; u32x4 xr[4];
#pragma unroll
              for (int i = 0; i < 4; ++i) xr[i] = (u32x4){0u, 0u, 0u, 0u};
#define X_FETCH(rnd_) do { const int sl_ = (xcc + (rnd_)) & 7; const bf16_t* xp_ = XN + ((size_t)tok0 + wave * 8 + (ul >> 5)) * D + sl_ * 256 + (ul & 31) * 8; \
                  _Pragma("unroll") for (int i_ = 0; i_ < 4; ++i_) xr[i_] = *(const u32x4*)(xp_ + (size_t)(2 * i_) * D); } while (0)
#define X_PUT() do { LAS unsigned char* d_ = XS + (ul >> 5) * 256 + (ul & 31) * 8; _Pragma("unroll") for (int i_ = 0; i_ < 4; ++i_) { \
                      const f32x4 lo_ = (f32x4){bflo(xr[i_].x), bfhi(xr[i_].x), bflo(xr[i_].y), bfhi(xr[i_].y)} * XU_SCALE, hi_ = (f32x4){bflo(xr[i_].z), bfhi(xr[i_].z), bflo(xr[i_].w), bfhi(xr[i_].w)} * XU_SCALE; \
                      *(LAS u32x2*)(d_ + i_ * 512) = pack8_fp8(lo_, hi_); } } while (0)
#define U_LOAD(BUF, step_) do { const int r_ = (step_) >> 3, ti_ = (step_) & 7, sl_ = (xcc + r_) & 7, tokl_ = wave * 8 + ti_; \
                  const unsigned char* ub_ = U8 + (size_t)sl_ * SLICE; \
                  _Pragma("unroll") for (int g_ = 0; g_ < 8; ++g_) { const unsigned e_ = PIDX[tokl_ * 128 + 16 * g_ + urho]; \
                      BUF[2 * g_] = *(const u32x4*)(ub_ + (e_ * 128u + (unsigned)uchi * 16u)); BUF[2 * g_ + 1] = *(const u32x4*)(ub_ + (e_ * 128u + (unsigned)uchi * 16u + 64u)); } } while (0)
#define U_COMP(BUF, step_) do { const int ti_ = (step_) & 7, tokl_ = wave * 8 + ti_; \
                  const LAS unsigned char* xs_ = XS + ti_ * 256 + 32 * (un & 3) + 16 * (ukq & 1); u32x4 y0_ = (u32x4){0u, 0u, 0u, 0u}, y1_ = y0_; const u32x4 z_ = y0_; \
                  if (bon) { y0_ = *(const LAS u32x4*)(xs_); y1_ = *(const LAS u32x4*)(xs_ + 128); } \
                  const u32x4 x0_ = bhi ? z_ : y0_, x1_ = bhi ? y0_ : z_, x2_ = bhi ? z_ : y1_, x3_ = bhi ? y1_ : z_; \
                  const pg8::i32x8_t XB0 = (pg8::i32x8_t){(int)x0_.x, (int)x0_.y, (int)x0_.z, (int)x0_.w, (int)x1_.x, (int)x1_.y, (int)x1_.z, (int)x1_.w}, XB1 = (pg8::i32x8_t){(int)x2_.x, (int)x2_.y, (int)x2_.z, (int)x2_.w, (int)x3_.x, (int)x3_.y, (int)x3_.z, (int)x3_.w}; \
                  _Pragma("unroll") for (int g_ = 0; g_ < 8; ++g_) { f32x4 acc_ = (f32x4){0.f, 0.f, 0.f, 0.f}; \
                      const u32x4 a0_ = BUF[2 * g_], a1_ = BUF[2 * g_ + 1]; \
                      acc_ = __builtin_amdgcn_mfma_scale_f32_16x16x128_f8f6f4((pg8::i32x8_t){(int)a0_.x, (int)a0_.y, (int)a0_.z, (int)a0_.w, 0, 0, 0, 0}, XB0, acc_, 4, 0, 0, 0x7f7f7f7f, 0, 0x7f7f7f7f); \
                      acc_ = __builtin_amdgcn_mfma_scale_f32_16x16x128_f8f6f4((pg8::i32x8_t){(int)a1_.x, (int)a1_.y, (int)a1_.z, (int)a1_.w, 0, 0, 0, 0}, XB1, acc_, 4, 0, 0, 0x7f7f7f7f, 0, 0x7f7f7f7f); \
                      float v_ = (uchi == 0) ? acc_[0] : ((uchi == 1) ? acc_[1] : ((uchi == 2) ? acc_[2] : acc_[3])); \
                      v_ += __shfl_xor(v_, 1); v_ += __shfl_xor(v_, 2); \
                      if (uchi == 0) { LAS float* p_ = AACC + tokl_ * 128 + 16 * g_ + 4 * (un >> 2) + ukq; *p_ = *p_ + v_; } } } while (0)
              X_FETCH(0); X_PUT();
              U_LOAD(bufA, 0);
              for (int step = 0; step < 64; step += 2) {
                  U_LOAD(bufB, step + 1);
                  if ((step & 7) == 2 && step + 8 < 64) X_FETCH((step >> 3) + 1);
                  U_COMP(bufA, step);
                  if (step + 2 < 64) U_LOAD(bufA, step + 2);
                  U_COMP(bufB, step + 1);
                  if ((step & 7) == 6 && step + 2 < 64) X_PUT();
              }
#undef X_FETCH
#undef X_PUT
#undef U_LOAD
#undef U_COMP
            }
            LAS unsigned char* CF = lds + 81920;
            float iscv = 0.f;
            if (sub == 0) { const int cl = fresh_lane();
#pragma unroll 1
            for (int ti = 0; ti < 8; ++ti) {
                const int tokl = wave * 8 + ti; const size_t tok = (size_t)tok0 + tokl;
                const float rstd2 = stat_rstd(SSQ2[tok], 1.0f / 2048.0f);
                float cv[2];
#pragma unroll
                for (int k = 0; k < 2; ++k) { const int sl = tokl * 128 + k * 64 + cl; const unsigned e = PIDX[sl];
                    const float a = AACC[sl] * USC[e] * (rstd2 * (1.0f / XU_SCALE)); const float ge = 0.5f * a * (1.0f + erff(a * 0.70710678118654752f));
                    cv[k] = PGT[sl] * ge * VSC[e] * P10SCALE; }
                const float m = wave_max(fmaxf(fabsf(cv[0]), fabsf(cv[1])));
                const float sc = (m > 0.f) ? 448.0f / m : 1.0f;
                if (cl == ti) iscv = (m > 0.f) ? m * (1.0f / 448.0f) : 1.0f;
#pragma unroll
                for (int k = 0; k < 2; ++k) CF[tokl * 128 + k * 64 + cl] = (unsigned char)(__builtin_amdgcn_cvt_pk_fp8_f32(__builtin_amdgcn_fmed3f(cv[k] * sc, -448.0f, 448.0f), 0.f, 0, false) & 0xff);
            } }
            __syncthreads();
            if (sub == 0 || sub == 3)
            { const int vl = fresh_lane(); const int vr = vl & 15, vkq = vl >> 4;
              const unsigned lds0 = (unsigned)(size_t)lds;
              const unsigned bufw = (wave < 4) ? 16384u + (unsigned)wave * 16384u : 98304u + (unsigned)(wave - 4) * 16384u;
              const unsigned rbw = 90112u + (unsigned)wave * 1024u;
              const unsigned dch0 = (unsigned)((vl & 7) ^ (vl >> 4)) * 16u, dch1 = dch0 ^ 64u; const int dslot = vl >> 3;
              LAS unsigned char* const trb = lds + bufw + (unsigned)(32 * vkq + vr) * 128u; const unsigned fr = (unsigned)((vr >> 1) & 7);
              float* const outb = P10STORE ? args.out : (float*)(ws + WS_Z);
              typedef int v2i_t __attribute__((ext_vector_type(2)));
              float res[4] = {0.f, 0.f, 0.f, 0.f}; unsigned oprev = 0u;
#define V_GATHER(p_) do { const int sl_ = (xcc + ((p_) >> 3)) & 7; const unsigned char* vb_ = V8 + (size_t)sl_ * SLICE; const int tokl_ = wave * 8 + ((p_) & 7); \
                  _Pragma("unroll") for (int d_ = 0; d_ < 16; ++d_) { const unsigned e_ = PIDX[tokl_ * 128 + 8 * d_ + dslot]; \
                      glds16s((const void*)vb_, e_ * 128u + ((d_ & 1) ? dch1 : dch0), (unsigned)__builtin_amdgcn_readfirstlane((int)(lds0 + bufw + (unsigned)d_ * 1024u))); } } while (0)
#define V_RESID(p_) do { const int sl_ = (xcc + ((p_) >> 3)) & 7; const bf16_t* rb_ = XN + ((size_t)tok0 + wave * 8 + ((p_) & 7)) * D + sl_ * 256; \
                  if (vl < 32) glds16s((const void*)rb_, (unsigned)vl * 16u, (unsigned)__builtin_amdgcn_readfirstlane((int)(lds0 + rbw + (unsigned)((p_) & 1) * 512u))); } while (0)
#define V_STORE() do { asm volatile("global_store_dword %0, %1, %5 nt\n\tglobal_store_dword %0, %2, %5 offset:256 nt\n\tglobal_store_dword %0, %3, %5 offset:512 nt\n\tglobal_store_dword %0, %4, %5 offset:768 nt" \
                      :: "v"(oprev), "v"(res[0]), "v"(res[1]), "v"(res[2]), "v"(res[3]), "s"(outb) : "memory"); } while (0)
              V_GATHER(0); V_RESID(0);
#pragma unroll 1
              for (int p = 0; p < 64; ++p) {
                  asm volatile("s_waitcnt vmcnt(0)" ::: "memory");
                  const int tokl = wave * 8 + (p & 7);
                  u32x4 c0 = (u32x4){0u, 0u, 0u, 0u}, c1 = c0;
                  if ((vr & 3) == 0) { c0 = *(const LAS u32x4*)(CF + tokl * 128 + 16 * vkq); c1 = *(const LAS u32x4*)(CF + tokl * 128 + 16 * vkq + 64); }
                  v2i_t t0[16], t1[16];
#pragma unroll
                  for (int cb = 0; cb < 16; ++cb) { LAS unsigned char* q_ = trb + (((unsigned)(cb >> 1) ^ fr) * 16u) + 8 * (cb & 1);
                      t0[cb] = __builtin_amdgcn_ds_read_tr4_b64_v2i32((LAS v2i_t*)q_); t1[cb] = __builtin_amdgcn_ds_read_tr4_b64_v2i32((LAS v2i_t*)(q_ + 2048)); }
                  asm volatile("s_waitcnt lgkmcnt(0)" ::: "memory");
#pragma unroll
                  for (int cb = 0; cb < 16; ++cb) { asm volatile("" : "+v"(t0[cb]), "+v"(t1[cb])); }
                  if (p > 0) V_STORE();
                  if (p + 1 < 64) { V_GATHER(p + 1); V_RESID(p + 1); }
                  f32x4 acc[4];
#pragma unroll
                  for (int c = 0; c < 4; ++c) acc[c] = (f32x4){0.f, 0.f, 0.f, 0.f};
#pragma unroll
                  for (int g = 0; g < 4; ++g) { const bool on = (vr >> 2) == g;
                      const pg8::i32x8_t A = (pg8::i32x8_t){on ? (int)c0.x : 0, on ? (int)c0.y : 0, on ? (int)c0.z : 0, on ? (int)c0.w : 0, on ? (int)c1.x : 0, on ? (int)c1.y : 0, on ? (int)c1.z : 0, on ? (int)c1.w : 0};
#pragma unroll
                      for (int c = 0; c < 4; ++c) acc[c] = __builtin_amdgcn_mfma_scale_f32_16x16x128_f8f6f4(A, (pg8::i32x8_t){t0[4 * c + g].x, t0[4 * c + g].y, t1[4 * c + g].x, t1[4 * c + g].y, 0, 0, 0, 0}, acc[c], 0, 4, 0, 0x7f7f7f7f, 0, 0x7f7f7f7f); }
                  const float isc = __builtin_bit_cast(float, __builtin_amdgcn_readlane(__builtin_bit_cast(int, iscv), p & 7));
                  const int sl = (xcc + (p >> 3)) & 7; const LAS unsigned short* rb = (const LAS unsigned short*)(lds + rbw + (p & 1) * 512) + vl;
#pragma unroll
                  for (int c = 0; c < 4; ++c) res[c] = __builtin_bit_cast(float, (unsigned)rb[64 * c] << 16) + isc * acc[c][0];
                  oprev = (unsigned)(((size_t)tok0 + tokl) * D + sl * 256 + vl) * 4u;
              }
              V_STORE();
              asm volatile("s_waitcnt vmcnt(0)" ::: "memory");
#undef V_GATHER
#undef V_RESID
#undef V_STORE
            }
        }
    }
#undef IN
#undef SEAM
#undef GRID_BAR
}

extern "C" void kernel_launch(void* const* d_in, const int* in_sizes, int n_in, void* d_out, int out_size, void* d_ws, size_t ws_size, hipStream_t stream) {
    static int grid = 0;
    if (grid == 0) {
        if (n_in != 28 || out_size != T * D || ws_size < WS_END) { fprintf(stderr, "kernel_launch: unexpected problem (n_in %d, out %d, ws %zu)\n", n_in, out_size, ws_size); grid = -1; return; }
        int dev = 0, cus = 0;
        if (hipGetDevice(&dev) != hipSuccess || hipDeviceGetAttribute(&cus, hipDeviceAttributeMultiprocessorCount, dev) != hipSuccess) { grid = -1; return; }
        if (hipFuncSetAttribute((const void*)fwd_t<0>, hipFuncAttributeMaxDynamicSharedMemorySize, LDS_BYTES) != hipSuccess) { fprintf(stderr, "kernel_launch: hipFuncSetAttribute failed\n"); grid = -1; return; }
        int per_cu = 0;
        if (hipOccupancyMaxActiveBlocksPerMultiprocessor(&per_cu, (const void*)fwd_t<0>, 512, LDS_BYTES) != hipSuccess || per_cu < 1) { fprintf(stderr, "kernel_launch: occupancy query says %d\n", per_cu); }
        (void)hipGetLastError();
        grid = cus;
    }
    if (grid < 0) return;
    (void)hipMemsetAsync((char*)d_ws + WS_CTL, 0, CTL_BYTES, stream);
    Args a{};
    for (int i = 0; i < 28; ++i) a.in[i] = (const float*)d_in[i];
    a.out = (float*)d_out; a.ws = (unsigned char*)d_ws;
#if MK_SPLIT
    for (int p = 0; p < NPHASE; ++p) { a.ph_lo = p; a.ph_hi = p + 1; a.dup = 0; hipLaunchKernelGGL(fwd_t<0>, dim3(grid), dim3(512), LDS_BYTES, stream, a);
        if (p == DUP_PHASE) { a.dup = 1;
            if (DUP_PHASE == 10) { (void)hipFuncSetAttribute((const void*)fwd_t<0, (DUP_PHASE == 10 ? (DUP_SUB == 0 ? 4 : DUP_SUB) : 0)>, hipFuncAttributeMaxDynamicSharedMemorySize, LDS_BYTES); hipLaunchKernelGGL((fwd_t<0, (DUP_PHASE == 10 ? (DUP_SUB == 0 ? 4 : DUP_SUB) : 0)>), dim3(grid), dim3(512), LDS_BYTES, stream, a); }
            else if (DUP_PHASE == 3 && DUP_SUB != 0) { (void)hipFuncSetAttribute((const void*)fwd_t<(DUP_PHASE == 3 ? DUP_SUB : 0)>, hipFuncAttributeMaxDynamicSharedMemorySize, LDS_BYTES); hipLaunchKernelGGL(fwd_t<(DUP_PHASE == 3 ? DUP_SUB : 0)>, dim3(grid), dim3(512), LDS_BYTES, stream, a); }
            else hipLaunchKernelGGL(fwd_t<0>, dim3(grid), dim3(512), LDS_BYTES, stream, a);
            a.dup = 0; } }
#else
    a.ph_lo = 0; a.ph_hi = NPHASE;
    hipLaunchKernelGGL(fwd_t<0>, dim3(grid), dim3(512), LDS_BYTES, stream, a);
#endif
}
```

```cpp
#include <hip/hip_runtime.h>
#include <cstdio>
#include <cstdint>

#ifndef MK_SPLIT
#define MK_SPLIT 0
#endif
#ifndef DUP_SUB
#define DUP_SUB 0
#endif
#ifndef DUP_PHASE
#define DUP_PHASE -1
#endif

#define LAS __attribute__((address_space(3)))
#define GAS __attribute__((address_space(1)))
typedef unsigned short bf16_t;
typedef short bf16x8 __attribute__((ext_vector_type(8)));
typedef float f32x2 __attribute__((ext_vector_type(2)));
typedef float f32x4 __attribute__((ext_vector_type(4)));
typedef float f32x16 __attribute__((ext_vector_type(16)));
typedef unsigned u32x2 __attribute__((ext_vector_type(2)));
typedef unsigned u32x4 __attribute__((ext_vector_type(4)));
typedef unsigned long long u64;

constexpr int NB = 4, SEQ = 4096, T = NB * SEQ, D = 2048, MEML = 256, MROWS = NB * MEML;
constexpr float EPS = 1e-6f, LOG2E = 1.4426950408889634f;
constexpr float FX = 1048576.0f, FXI = 1.0f / 1048576.0f;

constexpr size_t MiB = 1u << 20;
constexpr size_t WS_CTL = 0, CTL_BYTES = 2 * MiB;
constexpr size_t WS_WIN = 2 * MiB, WS_WOUT = 22 * MiB, WS_WCQ = 30 * MiB, WS_WCKV = 38 * MiB, WS_WCO = 54 * MiB, WS_WPQ = 62 * MiB;
constexpr size_t WS_KEYS = 70 * MiB, WS_SGUW = 70 * MiB + 512 * 1024, WS_MISC = 71 * MiB;
constexpr size_t WS_MEMN = 72 * MiB, WS_KC = 76 * MiB, WS_VCT = 80 * MiB, WS_LPART = 84 * MiB;
constexpr size_t WS_XN = 86 * MiB;
constexpr size_t WS_Z = 150 * MiB;
constexpr size_t WS_QC = WS_Z, WS_PC = WS_Z + 64 * MiB, WS_QP = WS_Z, WS_H8 = WS_Z + 96 * MiB;
constexpr size_t WS_VT = 278 * MiB;
constexpr size_t WS_MIX = 310 * MiB;
constexpr size_t WS_U8 = 374 * MiB, WS_V8 = 406 * MiB, WS_END = 438 * MiB;
constexpr size_t WS_USC = WS_MISC + 256 * 1024, WS_VSC = WS_MISC + 320 * 1024;
constexpr int CW_SGUQ = 64;
constexpr int CW_BAR = 4096;
constexpr size_t CB_SSQ1 = 64 * 1024, CB_SSQ2 = 192 * 1024, CB_SSQK = 320 * 1024, CB_SSQQ = 512 * 1024;

constexpr int RING_BYTES = 131072, MISC_OFF = RING_BYTES + 320, LDS_BYTES = 163840;

__device__ __forceinline__ unsigned f2bf(float f) { unsigned u = __builtin_bit_cast(unsigned, f); return (u + 0x7fffu + ((u >> 16) & 1u)) >> 16; }
__device__ __forceinline__ unsigned pk2(float lo, float hi) { return f2bf(lo) | (f2bf(hi) << 16); }
__device__ __forceinline__ float bflo(unsigned w) { return __builtin_bit_cast(float, w << 16); }
__device__ __forceinline__ float bfhi(unsigned w) { return __builtin_bit_cast(float, w & 0xffff0000u); }
typedef __bf16 bf16x2v_t __attribute__((ext_vector_type(2)));
__device__ __forceinline__ unsigned cvt_pk_bf16(float lo, float hi) { return __builtin_bit_cast(unsigned, __builtin_convertvector((f32x2){lo, hi}, bf16x2v_t)); }
template <int CTRL> __device__ __forceinline__ float dpp_mov(float v) { return __builtin_bit_cast(float, __builtin_amdgcn_mov_dpp(__builtin_bit_cast(int, v), CTRL, 0xF, 0xF, true)); }
__device__ __forceinline__ float quad_sum(float v) { v += dpp_mov<0xB1>(v); v += dpp_mov<0x4E>(v); return v; }
__device__ __forceinline__ float rows_sum(float s) {
    { auto r = __builtin_amdgcn_permlane16_swap(__float_as_uint(s), __float_as_uint(s), false, false); s = __uint_as_float(r[0]) + __uint_as_float(r[1]); }
    { auto r = __builtin_amdgcn_permlane32_swap(__float_as_uint(s), __float_as_uint(s), false, false); s = __uint_as_float(r[0]) + __uint_as_float(r[1]); }
    return s;
}
__device__ __forceinline__ float wave_sum(float v) { v = quad_sum(v); v += dpp_mov<0x141>(v); v += dpp_mov<0x140>(v); return rows_sum(v); }
__device__ __forceinline__ float wave_max(float v) {
    v = fmaxf(v, dpp_mov<0xB1>(v)); v = fmaxf(v, dpp_mov<0x4E>(v)); v = fmaxf(v, dpp_mov<0x141>(v)); v = fmaxf(v, dpp_mov<0x140>(v));
    { auto r = __builtin_amdgcn_permlane16_swap(__float_as_uint(v), __float_as_uint(v), false, false); v = fmaxf(__uint_as_float(r[0]), __uint_as_float(r[1])); }
    { auto r = __builtin_amdgcn_permlane32_swap(__float_as_uint(v), __float_as_uint(v), false, false); v = fmaxf(__uint_as_float(r[0]), __uint_as_float(r[1])); }
    return v;
}
__device__ __forceinline__ float stat_rstd(u64 s, float inv_n) { return 1.0f / sqrtf((float)s * FXI * inv_n + EPS); }
__device__ __forceinline__ void stat_add(u64* p, float v) { __hip_atomic_fetch_add(p, (u64)(v * FX + 0.5f), __ATOMIC_RELAXED, __HIP_MEMORY_SCOPE_AGENT); }

__device__ __forceinline__ u32x2 pack8_fp8(f32x4 a, f32x4 b) {
#pragma unroll
    for (int i = 0; i < 4; ++i) { a[i] = __builtin_amdgcn_fmed3f(a[i], -448.0f, 448.0f); b[i] = __builtin_amdgcn_fmed3f(b[i], -448.0f, 448.0f); }
    int lo = __builtin_amdgcn_cvt_pk_fp8_f32(a[0], a[1], 0, false); lo = __builtin_amdgcn_cvt_pk_fp8_f32(a[2], a[3], lo, true);
    int hi = __builtin_amdgcn_cvt_pk_fp8_f32(b[0], b[1], 0, false); hi = __builtin_amdgcn_cvt_pk_fp8_f32(b[2], b[3], hi, true);
    return (u32x2){(unsigned)lo, (unsigned)hi};
}
__device__ __forceinline__ void st_fp8_pair(unsigned char* rowbase, u32x2 x, u32x2 y, int fq) {
    auto r0 = __builtin_amdgcn_permlane16_swap(x.x, y.x, false, false); auto r1 = __builtin_amdgcn_permlane16_swap(x.y, y.y, false, false);
    *(u32x4*)(rowbase + (fq & 1) * 128 + (fq >> 1) * 16) = (u32x4){r0[0], r1[0], r0[1], r1[1]};
}
constexpr float XU_SCALE = 16.0f;
constexpr float W8_SCALE = 2048.0f, A8_SCALE = 16.0f, OC8_SCALE = 64.0f;

__device__ __forceinline__ void glds16s(const void* sbase, unsigned voff, unsigned lds_dst) { unsigned keep;
    asm volatile("s_mov_b32 %0, m0\n\ts_mov_b32 m0, %3\n\ts_nop 2\n\tglobal_load_lds_dwordx4 %1, %2\n\ts_mov_b32 m0, %0" : "=&s"(keep) : "v"(voff), "s"(sbase), "s"(lds_dst) : "memory"); }

namespace pg8 {
constexpr int BM = 256, BK = 64, HALF = 128, HTB = HALF * BK * 2, STAGE_BYTES = 8 * HTB, NXCD = 8, WGM = 8;
__host__ __device__ __forceinline__ int lds_byte(int r, int c) { const int st = (r >> 4) * 2 + (c >> 5), rr = r & 15, cc = c & 31, ob = rr * 64 + cc * 2; return st * 1024 + (ob ^ (((ob >> 9) & 1) << 5)); }
__host__ __device__ __forceinline__ void stage_rc(int b, int& R, int& C) { const int st = b / 1024, sb = b % 1024, swz = sb ^ (((sb >> 9) & 1) << 5); R = (st >> 1) * 16 + swz / 64; C = (st & 1) * 32 + (swz % 64) / 2; }
__host__ __device__ __forceinline__ int perm32(int rho) { const int n = rho >> 4, i = rho & 15; return 8 * (i >> 2) + 4 * n + (i & 3); }

typedef int i32x8_t __attribute__((ext_vector_type(8)));
typedef short bf16x16_t __attribute__((ext_vector_type(16)));
struct Unit { const char* a; const char* b; int pm, pn, z; };
struct Gemm { int lda, ldb, K; };

struct PlainOrder {
    const char* A; const char* Bt; int lda, ldb, nM, nN, nwg, G, c;
    __device__ void init(const void* A_, const void* Bt_, int lda_, int ldb_, int M, int N, int G_, int c_) { A = (const char*)A_; Bt = (const char*)Bt_; lda = lda_; ldb = ldb_; nM = M / BM; nN = N / BM; nwg = nM * nN; G = G_; c = c_; }
    __device__ bool next(int i, Unit& u) const {
        const long L = (long)i * G + c; if (L >= nwg) return false;
        int wgid = (int)L; { const int q = nwg / NXCD, r = nwg % NXCD, xcd = wgid % NXCD, off = wgid / NXCD; wgid = (xcd < r ? xcd * (q + 1) : r * (q + 1) + (xcd - r) * q) + off; }
        const int nig = WGM * nN, gid = wgid / nig, fm = gid * WGM, gsz = (nM - fm) < WGM ? (nM - fm) : WGM;
        u.pm = fm + ((wgid % nig) % gsz); u.pn = (wgid % nig) / gsz; u.z = 0;
        u.a = A + (size_t)u.pm * BM * lda * 2; u.b = Bt + (size_t)u.pn * BM * ldb * 2; return true;
    }
    __device__ __forceinline__ void a_ready(const Unit&) const {}
    __device__ __forceinline__ void done(const Unit&) const {}
};
struct BatchOrder {
    const char* A; const char* Bt; int lda, ldb, nM, nN, nwg, G, v; size_t sAb, sAh, sBb, sBh;
    __device__ bool next(int i, Unit& u) const {
        const long L = (long)i * G + v; if (L >= nwg) return false;
        const int per = nM * nN, z = (int)L / per, rem = (int)L % per;
        u.z = z; u.pm = rem / nN; u.pn = rem % nN;
        u.a = A + (size_t)(z >> 2) * sAb + (size_t)(z & 3) * sAh + (size_t)u.pm * BM * lda * 2;
        u.b = Bt + (size_t)(z >> 2) * sBb + (size_t)(z & 3) * sBh + (size_t)u.pn * BM * ldb * 2; return true;
    }
    __device__ __forceinline__ void a_ready(const Unit&) const {}
    __device__ __forceinline__ void done(const Unit&) const {}
};
template <int MODE> struct ChainOrder {
    const char* A; const char* Bt; int lda, ldb, G, v; size_t sAb, sAh, sBb, sBh;
    __device__ bool next(int i, Unit& u) const {
        const int j = i >> 1, q = i & 1; const long L = (long)j * G + v; if (L >= 256) return false;
        const int z = (int)L >> 4, pm16 = (int)L & 15, b = z >> 2, h = z & 3;
        if (MODE == 5) { u.z = 0; u.pm = b * 16 + pm16; u.pn = 2 * h + q; u.a = A + (size_t)u.pm * BM * lda * 2; u.b = Bt + (size_t)u.pn * BM * ldb * 2; }
        else { u.z = z; u.pm = pm16; u.pn = q; u.a = A + (size_t)b * sAb + (size_t)h * sAh + (size_t)pm16 * BM * lda * 2; u.b = Bt + (size_t)b * sBb + (size_t)h * sBh + (size_t)q * BM * ldb * 2; }
        return true;
    }
    __device__ __forceinline__ void a_ready(const Unit&) const {}
    __device__ __forceinline__ void done(const Unit&) const {}
};
struct PairOrder {
    const char *A0, *B0, *A1, *B1; int lda, ldb, nM0, nN0, nM1, nN1, G, v;
    __device__ bool next(int i, Unit& u) const {
        const int L = i * G + v; const int n0 = nM0 * nN0, n1 = nM1 * nN1; if (L >= n0 + n1) return false;
        if (L < n0) { u.z = 0; u.pm = L / nN0; u.pn = L % nN0; u.a = A0 + (size_t)u.pm * BM * lda * 2; u.b = B0 + (size_t)u.pn * BM * ldb * 2; }
        else { const int r = L - n0; u.z = 1; u.pm = r / nN1; u.pn = r % nN1; u.a = A1 + (size_t)u.pm * BM * lda * 2; u.b = B1 + (size_t)u.pn * BM * ldb * 2; }
        return true;
    }
    __device__ __forceinline__ void a_ready(const Unit&) const {}
    __device__ __forceinline__ void done(const Unit&) const {}
};

__device__ __forceinline__ f32x2 gelu_pk(f32x2 v) {
    const f32x2 av = __builtin_elementwise_abs(v), d = av * 0.2316418882f + 1.0f;
    f32x2 t; t.x = __builtin_amdgcn_rcpf(d.x); t.y = __builtin_amdgcn_rcpf(d.y);
    f32x2 q = t * 0.5307027145f + (-0.7265760135f); q = q * t + 0.7107068705f; q = q * t + (-0.142248368f); q = q * t + 0.127414796f; q = q * t;
    const f32x2 s = (v * v) * (-0.72134752044f);
    f32x2 e; e.x = __builtin_amdgcn_exp2f(s.x); e.y = __builtin_amdgcn_exp2f(s.y);
    const f32x2 m = v * (q * e), r = v - m;
    f32x2 o; o.x = v.x < 0.f ? m.x : r.x; o.y = v.y < 0.f ? m.y : r.y; return o;
}
__device__ __forceinline__ f32x4 gelu4(f32x4 v) { const f32x2 a = gelu_pk((f32x2){v[0], v[1]}), b = gelu_pk((f32x2){v[2], v[3]}); return (f32x4){a.x, a.y, b.x, b.y}; }

template <bool GELU, bool COLS, bool ROWS, bool SSQ> struct EpiB {
    static constexpr bool PERM = true;
    bf16_t* O; int ldc; int gelu_pn; const float* cs; int cmask; const u64* rssq; float r_inv_n; u64* ssq; int nh; int tph; float oscale = 1.0f;
    __device__ __forceinline__ void operator()(const f32x4 (&acc)[2][2][4][2], const Unit& u, int wr, int wc, int fr, int fq) const {
        const int row0 = u.pm * BM + wr * 64 + fr, col0 = u.pn * BM + wc * 32 + 8 * fq;
        const bool dog = GELU && (u.pn < gelu_pn);
        f32x4 cv[2][2];
        if (COLS) {
#pragma unroll
            for (int bj = 0; bj < 2; ++bj)
#pragma unroll
                for (int n = 0; n < 2; ++n) cv[bj][n] = *(const f32x4*)(cs + ((col0 + bj * HALF + 4 * n) & cmask));
        }
#pragma unroll
        for (int ai = 0; ai < 2; ++ai)
#pragma unroll
            for (int m = 0; m < 4; ++m) {
                const int row = row0 + ai * HALF + m * 16; bf16_t* rowp = O + (size_t)row * ldc + col0;
                float rs = 1.f; if (ROWS) rs = stat_rstd(rssq[row], r_inv_n);
                float s = 0.f;
#pragma unroll
                for (int bj = 0; bj < 2; ++bj) { f32x4 v0 = acc[ai][bj][m][0] * oscale, v1 = acc[ai][bj][m][1] * oscale;
                    if (SSQ) s += (v0[0] * v0[0] + v0[1] * v0[1]) + (v0[2] * v0[2] + v0[3] * v0[3]) + (v1[0] * v1[0] + v1[1] * v1[1]) + (v1[2] * v1[2] + v1[3] * v1[3]);
                    if (GELU) { if (dog) { v0 = gelu4(v0); v1 = gelu4(v1); } }
                    if (COLS) { v0 = v0 * cv[bj][0]; v1 = v1 * cv[bj][1]; }
                    if (ROWS) { v0 = v0 * rs; v1 = v1 * rs; }
                    u32x4 w; w.x = cvt_pk_bf16(v0[0], v0[1]); w.y = cvt_pk_bf16(v0[2], v0[3]); w.z = cvt_pk_bf16(v1[0], v1[1]); w.w = cvt_pk_bf16(v1[2], v1[3]);
                    *(u32x4*)(rowp + bj * HALF) = w; }
                if (SSQ) { s = rows_sum(s); if (fq == 0) stat_add(ssq + (size_t)row * nh + u.pn / tph, s); }
            }
    }
};
struct EpiQK {
    static constexpr bool PERM = true;
    bf16_t* O; int ldc; const float* qg; const float* kg; LAS float* xq;
    __device__ __forceinline__ void operator()(const f32x4 (&acc)[2][2][4][2], const Unit& u, int wr, int wc, int fr, int fq) const {
        const int row0 = u.pm * BM + wr * 64 + fr, col0 = u.pn * BM + wc * 32 + 8 * fq;
        const bool isq = u.pn < 4; const float* gsrc = (isq ? qg : kg) + 32 * (wc & 1) + 8 * fq; const float gm = isq ? 0.125f * LOG2E : 1.0f;
        const f32x4 g0 = *(const f32x4*)gsrc * gm, g1 = *(const f32x4*)(gsrc + 4) * gm;
        float part[2][4][2];
#pragma unroll
        for (int ai = 0; ai < 2; ++ai)
#pragma unroll
            for (int m = 0; m < 4; ++m)
#pragma unroll
                for (int bj = 0; bj < 2; ++bj) { const f32x4 v0 = acc[ai][bj][m][0], v1 = acc[ai][bj][m][1];
                    float s = (v0[0] * v0[0] + v0[1] * v0[1]) + (v0[2] * v0[2] + v0[3] * v0[3]) + (v1[0] * v1[0] + v1[1] * v1[1]) + (v1[2] * v1[2] + v1[3] * v1[3]);
                    s = rows_sum(s); part[ai][m][bj] = s;
                    if (fq == 0) xq[((wr * 4 + wc) * 2 + bj) * 128 + ai * 64 + m * 16 + fr] = s; }
        asm volatile("s_waitcnt lgkmcnt(0)" ::: "memory"); __builtin_amdgcn_s_barrier(); asm volatile("" ::: "memory");
#pragma unroll
        for (int ai = 0; ai < 2; ++ai)
#pragma unroll
            for (int m = 0; m < 4; ++m) { const int row = row0 + ai * HALF + m * 16; bf16_t* rowp = O + (size_t)row * ldc + col0;
#pragma unroll
                for (int bj = 0; bj < 2; ++bj) { const float tot = part[ai][m][bj] + xq[((wr * 4 + (wc ^ 1)) * 2 + bj) * 128 + ai * 64 + m * 16 + fr];
                    const float rstd = 1.0f / sqrtf(tot * (1.0f / 64.0f) + EPS);
                    const f32x4 v0 = acc[ai][bj][m][0] * rstd * g0, v1 = acc[ai][bj][m][1] * rstd * g1;
                    u32x4 w; w.x = cvt_pk_bf16(v0[0], v0[1]); w.y = cvt_pk_bf16(v0[2], v0[3]); w.z = cvt_pk_bf16(v1[0], v1[1]); w.w = cvt_pk_bf16(v1[2], v1[3]);
                    *(u32x4*)(rowp + bj * HALF) = w; } }
    }
};
struct EpiKV {
    static constexpr bool PERM = true;
    bf16_t* KC; bf16_t* VCT; const float* kgqg; u64* ssqk; float oscale;
    __device__ __forceinline__ void operator()(const f32x4 (&acc)[2][2][4][2], const Unit& u, int wr, int wc, int fr, int fq) const {
        const int row0 = u.pm * BM + wr * 64 + fr, col0 = u.pn * BM + wc * 32 + 8 * fq;
        if (u.z == 0) { EpiB<false, true, false, true> e{KC, D, 0, kgqg, 511, nullptr, 0.f, ssqk, 4, 2, oscale}; e(acc, u, wr, wc, fr, fq); }
        else { EpiB<false, false, false, false> e{VCT, MROWS, 0, nullptr, 0, nullptr, 0.f, nullptr, 0, 1, oscale}; e(acc, u, wr, wc, fr, fq); }
        (void)row0; (void)col0;
    }
};
template <bool XF32> struct EpiH {
    static constexpr bool PERM = true;
    const void* base; bf16_t* H; u64* ssq; unsigned char* H8; float accscale;
    __device__ __forceinline__ void operator()(const f32x4 (&acc)[2][2][4][2], const Unit& u, int wr, int wc, int fr, int fq) const {
        const int row0 = u.pm * BM + wr * 64 + fr, col0 = u.pn * BM + wc * 32 + 8 * fq;
        f32x4 xb[3][2][2]; u32x4 rb[3][2];
#define EH_LOAD(it_) do { const size_t off_ = (size_t)(row0 + ((it_) >> 2) * HALF + ((it_) & 3) * 16) * D + col0; \
            _Pragma("unroll") for (int bj = 0; bj < 2; ++bj) { \
                if (XF32) { const float* xp = (const float*)base + off_ + bj * HALF; xb[(it_) % 3][bj][0] = *(const f32x4*)xp; xb[(it_) % 3][bj][1] = *(const f32x4*)(xp + 4); } \
                else rb[(it_) % 3][bj] = *(const u32x4*)((const bf16_t*)base + off_ + bj * HALF); } } while (0)
        EH_LOAD(0); EH_LOAD(1);
#pragma unroll
        for (int it = 0; it < 8; ++it) {
            const int ai = it >> 2, m = it & 3;
            if (it + 2 < 8) EH_LOAD(it + 2);
            const int row = row0 + ai * HALF + m * 16; const size_t off = (size_t)row * D + col0; float s = 0.f; u32x2 p8[2];
#pragma unroll
            for (int bj = 0; bj < 2; ++bj) {
                f32x4 b0, b1;
                if (XF32) { b0 = xb[it % 3][bj][0]; b1 = xb[it % 3][bj][1]; }
                else { const u32x4 w = rb[it % 3][bj]; b0 = (f32x4){bflo(w.x), bfhi(w.x), bflo(w.y), bfhi(w.y)}; b1 = (f32x4){bflo(w.z), bfhi(w.z), bflo(w.w), bfhi(w.w)}; }
                const f32x4 h0 = b0 + acc[ai][bj][m][0] * accscale, h1 = b1 + acc[ai][bj][m][1] * accscale;
                s += (h0[0] * h0[0] + h0[1] * h0[1]) + (h0[2] * h0[2] + h0[3] * h0[3]) + (h1[0] * h1[0] + h1[1] * h1[1]) + (h1[2] * h1[2] + h1[3] * h1[3]);
                u32x4 o; o.x = cvt_pk_bf16(h0[0], h0[1]); o.y = cvt_pk_bf16(h0[2], h0[3]); o.z = cvt_pk_bf16(h1[0], h1[1]); o.w = cvt_pk_bf16(h1[2], h1[3]);
                *(u32x4*)(H + off + bj * HALF) = o;
                if (H8) p8[bj] = pack8_fp8(h0 * A8_SCALE, h1 * A8_SCALE); }
            if (H8) st_fp8_pair(H8 + off - 8 * fq, p8[0], p8[1], fq);
            s = rows_sum(s); if (fq == 0) stat_add(ssq + row, s);
            asm volatile("" ::: "memory");
        }
#undef EH_LOAD
    }
};
struct EpiS {
    static constexpr bool PERM = true;
    bf16_t* P; const u64* ssq1; const u64* ssqq; const u64* ssqk; float* lpart; float cshift;
    __device__ __forceinline__ void operator()(const f32x4 (&acc)[2][2][4][2], const Unit& u, int wr, int wc, int fr, int fq) const {
        const int b = u.z >> 2, h = u.z & 3;
        const int row0 = b * SEQ + u.pm * BM + wr * 64 + fr, key0 = wc * 32 + 8 * fq;
        float fk[2][2][4];
#pragma unroll
        for (int bj = 0; bj < 2; ++bj)
#pragma unroll
            for (int n = 0; n < 2; ++n)
#pragma unroll
                for (int e = 0; e < 4; ++e) fk[bj][n][e] = stat_rstd(ssqk[(size_t)(b * MEML + key0 + bj * HALF + 4 * n + e) * 4 + h], 1.0f / 512.0f);
#pragma unroll
        for (int ai = 0; ai < 2; ++ai)
#pragma unroll
            for (int m = 0; m < 4; ++m) {
                const int row = row0 + ai * HALF + m * 16;
                const float r1 = stat_rstd(ssq1[row], 1.0f / 2048.0f);
                const float sq = (float)ssqq[(size_t)row * 4 + h] * FXI;
                const float rq = 1.0f / sqrtf(r1 * r1 * sq * (1.0f / 512.0f) + EPS);
                const float fr_ = r1 * rq * (0.044194173824159216f * LOG2E);
                float s = 0.f; bf16_t* rowp = P + (size_t)row * 1024 + h * 256 + key0;
#pragma unroll
                for (int bj = 0; bj < 2; ++bj) { float p[8];
#pragma unroll
                    for (int n = 0; n < 2; ++n)
#pragma unroll
                        for (int e = 0; e < 4; ++e) { p[4 * n + e] = __builtin_amdgcn_exp2f(acc[ai][bj][m][n][e] * fr_ * fk[bj][n][e] - cshift); s += p[4 * n + e]; }
                    u32x4 w; w.x = cvt_pk_bf16(p[0], p[1]); w.y = cvt_pk_bf16(p[2], p[3]); w.z = cvt_pk_bf16(p[4], p[5]); w.w = cvt_pk_bf16(p[6], p[7]);
                    *(u32x4*)(rowp + bj * HALF) = w; }
                s = rows_sum(s); if (fq == 0) lpart[((size_t)row * 4 + h) * 4 + wc] = s;
            }
    }
};
struct EpiPV {
    static constexpr bool PERM = true;
    unsigned char* O; const float* lpart;
    __device__ __forceinline__ void operator()(const f32x4 (&acc)[2][2][4][2], const Unit& u, int wr, int wc, int fr, int fq) const {
        const int b = u.z >> 2, h = u.z & 3;
        const int row0 = b * SEQ + u.pm * BM + wr * 64 + fr, col0 = h * 512 + u.pn * BM + wc * 32 + 8 * fq;
#pragma unroll
        for (int ai = 0; ai < 2; ++ai)
#pragma unroll
            for (int m = 0; m < 4; ++m) {
                const int row = row0 + ai * HALF + m * 16; const f32x4 lp = *(const f32x4*)(lpart + ((size_t)row * 4 + h) * 4);
                const float inv = OC8_SCALE / ((lp[0] + lp[1]) + (lp[2] + lp[3])); unsigned char* rowp = O + (size_t)row * D + col0;
                st_fp8_pair(rowp - 8 * fq, pack8_fp8(acc[ai][0][m][0] * inv, acc[ai][0][m][1] * inv), pack8_fp8(acc[ai][1][m][0] * inv, acc[ai][1][m][1] * inv), fq);
            }
    }
};

template <bool FP8 = false, class Epi, class Sched, bool ALIGN_EPI = true>
__device__ __forceinline__ void gemm_phase(LAS unsigned char* lds, const Gemm g, const Sched& S, const Epi& E) {
    const int tid = threadIdx.x, wid = __builtin_amdgcn_readfirstlane(tid >> 6), lane = tid & 63, wr = wid >> 2, wc = wid & 3, fr = lane & 15, fq = lane >> 4;
    const int K = g.K, nt = K / BK;
    unsigned voffA[2], voffB[2];
#pragma unroll
    for (int i = 0; i < 2; ++i) { int R, C; stage_rc(tid * 16 + i * 8192, R, C); const int Rb = Epi::PERM ? ((R & ~31) + perm32(R & 31)) : R;
        voffA[i] = (unsigned)(R * g.lda + C) * 2u; voffB[i] = (unsigned)(Rb * g.ldb + C) * 2u; }
    const size_t kstep = (size_t)(BK * 2);
    const size_t hstepA = (size_t)HALF * g.lda * 2, hstepB = (size_t)HALF * g.ldb * 2;
    const unsigned ldsw = (unsigned)wid * 1024u; const unsigned lds0 = (unsigned)(size_t)lds;
    const int aoff = lds_byte(wr * 64 + fr, fq * 8), boff = lds_byte(wc * 32 + fr, fq * 8);
#define PG8_SA(b, h) (((b) * 2 + (h)) * HTB)
#define PG8_SB(b, h) ((4 + (b) * 2 + (h)) * HTB)
#define PG8_STAGE(bufoff, gbase, voff) do { _Pragma("unroll") for (int _i = 0; _i < 2; ++_i) \
        glds16s((const void*)(gbase), (voff)[_i], (unsigned)__builtin_amdgcn_readfirstlane((int)(lds0 + (unsigned)(bufoff) + ldsw + (unsigned)_i * 8192u))); } while (0)
#define PG8_LDA(dst, b, h) do { _Pragma("unroll") for (int m = 0; m < 4; ++m) { dst[m].lo = *(const LAS bf16x8*)(lds + PG8_SA(b, h) + aoff + m * 2048); dst[m].hi = *(const LAS bf16x8*)(lds + PG8_SA(b, h) + aoff + m * 2048 + 1024); } } while (0)
#define PG8_LDB(dst, b, h) do { _Pragma("unroll") for (int n = 0; n < 2; ++n) { dst[n].lo = *(const LAS bf16x8*)(lds + PG8_SB(b, h) + boff + n * 2048); dst[n].hi = *(const LAS bf16x8*)(lds + PG8_SB(b, h) + boff + n * 2048 + 1024); } } while (0)
#define PG8_MMA(ai, bj, At, Bt) do { __builtin_amdgcn_s_setprio(1); _Pragma("unroll") for (int m = 0; m < 4; ++m) _Pragma("unroll") for (int n = 0; n < 2; ++n) { \
        if constexpr (FP8) asm volatile("v_mfma_scale_f32_16x16x128_f8f6f4 %0, %1, %2, %0, %3, %3 op_sel_hi:[0,0,0]" : "+v"(acc[ai][bj][m][n]) : "v"(__builtin_bit_cast(i32x8_t, Bt[n])), "v"(__builtin_bit_cast(i32x8_t, At[m])), "v"(0x7f7f7f7f));   \
        else { acc[ai][bj][m][n] = __builtin_amdgcn_mfma_f32_16x16x32_bf16(Bt[n].lo, At[m].lo, acc[ai][bj][m][n], 0, 0, 0); acc[ai][bj][m][n] = __builtin_amdgcn_mfma_f32_16x16x32_bf16(Bt[n].hi, At[m].hi, acc[ai][bj][m][n], 0, 0, 0); } } \
        __builtin_amdgcn_s_setprio(0); } while (0)
#define PG8_WAIT_V(n) asm volatile("s_waitcnt vmcnt(" #n ")" ::: "memory")
#define PG8_WAIT_L(n) asm volatile("s_waitcnt lgkmcnt(" #n ")" ::: "memory")
#define PG8_BAR __builtin_amdgcn_s_barrier()
#define PG8_SCHED __builtin_amdgcn_sched_barrier(0)
    Unit cur, nxt; int ui = 0;
    if (!S.next(0, cur)) return;
    f32x4 acc[2][2][4][2];
#pragma unroll
    for (int a = 0; a < 2; ++a)
#pragma unroll
        for (int b = 0; b < 2; ++b)
#pragma unroll
            for (int m = 0; m < 4; ++m)
#pragma unroll
                for (int n = 0; n < 2; ++n) acc[a][b][m][n] = (f32x4){0.f, 0.f, 0.f, 0.f};
    bf16x16_t At[4], B0[2], B1[2];
    const char* cA = cur.a; const char* cB = cur.b;
    S.a_ready(cur);
    PG8_STAGE(PG8_SB(0, 0), cB, voffB); PG8_STAGE(PG8_SB(0, 1), cB + hstepB, voffB); PG8_STAGE(PG8_SA(0, 0), cA, voffA); PG8_STAGE(PG8_SA(0, 1), cA + hstepA, voffA);
    if (wr == 1) PG8_BAR;
    PG8_WAIT_V(2); PG8_BAR;
    PG8_STAGE(PG8_SB(1, 0), cB + kstep, voffB); PG8_STAGE(PG8_SA(1, 0), cA + kstep, voffA); PG8_STAGE(PG8_SB(1, 1), cB + hstepB + kstep, voffB);
    PG8_WAIT_V(6); PG8_BAR;
    for (;;) {
        const bool has_next = S.next(ui + 1, nxt);
        const char* nA = has_next ? nxt.a : cA; const char* nB = has_next ? nxt.b : cB;
        for (int t = 0; t < nt; t += 2) {
            const bool last = (t == nt - 2);
            const char* a1 = cA + (size_t)(t + 1) * kstep;
            const char* a2 = last ? nA : cA + (size_t)(t + 2) * kstep; const char* b2 = last ? nB : cB + (size_t)(t + 2) * kstep;
            const char* a3 = a2 + kstep; const char* b3 = b2 + kstep;
            if (last && has_next) S.a_ready(nxt);
            PG8_LDB(B0, 0, 0); PG8_LDB(B1, 0, 1); PG8_SCHED; PG8_LDA(At, 0, 0); PG8_STAGE(PG8_SA(1, 1), a1 + hstepA, voffA);
            PG8_WAIT_V(8); PG8_WAIT_L(0); PG8_BAR; PG8_MMA(0, 0, At, B0); PG8_MMA(0, 1, At, B1); PG8_BAR; PG8_SCHED;
            PG8_LDA(At, 0, 1); PG8_STAGE(PG8_SB(0, 0), b2, voffB); PG8_STAGE(PG8_SB(0, 1), b2 + hstepB, voffB); PG8_STAGE(PG8_SA(0, 0), a2, voffA);
            PG8_WAIT_V(8); PG8_WAIT_L(0); PG8_BAR; PG8_MMA(1, 0, At, B0); PG8_MMA(1, 1, At, B1); PG8_BAR; PG8_SCHED;
            PG8_LDB(B0, 1, 0); PG8_LDB(B1, 1, 1); PG8_SCHED; PG8_LDA(At, 1, 0); PG8_STAGE(PG8_SA(0, 1), a2 + hstepA, voffA);
            PG8_WAIT_V(8); PG8_WAIT_L(0); PG8_BAR; PG8_MMA(0, 0, At, B0); PG8_MMA(0, 1, At, B1); PG8_BAR; PG8_SCHED;
            PG8_LDA(At, 1, 1); PG8_STAGE(PG8_SB(1, 0), b3, voffB); PG8_STAGE(PG8_SB(1, 1), b3 + hstepB, voffB); PG8_STAGE(PG8_SA(1, 0), a3, voffA);
            PG8_WAIT_V(8); PG8_WAIT_L(0); PG8_BAR; PG8_MMA(1, 0, At, B0); PG8_MMA(1, 1, At, B1); PG8_BAR; PG8_SCHED;
        }
        if constexpr (ALIGN_EPI) { if (wr == 0) PG8_BAR; }
        if constexpr (FP8) asm volatile("s_nop 15\n\ts_nop 15" ::: "memory");
        E(acc, cur, wr, wc, fr, fq); S.done(cur);
        if (!has_next) break;
#pragma unroll
        for (int a = 0; a < 2; ++a)
#pragma unroll
            for (int b = 0; b < 2; ++b)
#pragma unroll
                for (int m = 0; m < 4; ++m)
#pragma unroll
                    for (int n = 0; n < 2; ++n) acc[a][b][m][n] = (f32x4){0.f, 0.f, 0.f, 0.f};
        cur = nxt; cA = nA; cB = nB; ++ui;
        if constexpr (ALIGN_EPI) { if (wr == 1) PG8_BAR; }
    }
    PG8_WAIT_V(0);
    if constexpr (!ALIGN_EPI) { if (wr == 0) PG8_BAR; }
    PG8_BAR;
#undef PG8_SA
#undef PG8_SB
#undef PG8_STAGE
#undef PG8_LDA
#undef PG8_LDB
#undef PG8_MMA
#undef PG8_WAIT_V
#undef PG8_WAIT_L
#undef PG8_BAR
#undef PG8_SCHED
}
}

#define XB_TMO      128
#define XB_XCNT(j)  (256  + 64 * (j))
#define XB_XSUB(j)  (1280 + 64 * (j))
#define XB_XGEN(j)  (2304 + 64 * (j))
#define XB_TOP      3328
#define XB_TOPGEN   3392
#define XCD_BAR_WORDS 3456
#define XB_SPIN_CAP (1u << 18)
__device__ __forceinline__ unsigned xb_ld(unsigned* p)              { return __hip_atomic_load(p, __ATOMIC_RELAXED, __HIP_MEMORY_SCOPE_AGENT); }
__device__ __forceinline__ unsigned xb_add(unsigned* p, unsigned v) { return __hip_atomic_fetch_add(p, v, __ATOMIC_RELAXED, __HIP_MEMORY_SCOPE_AGENT); }
__device__ __forceinline__ unsigned xb_xcc_id() { return (unsigned)__builtin_amdgcn_s_getreg((3 << 11) | 20) & 0xFu; }
#define XB_SPIN(cond, bar) do { unsigned _sp = 0; while (cond) { __builtin_amdgcn_s_sleep(1); \
    if ((++_sp & 255u) == 0u) { if (xb_ld(&(bar)[XB_TMO])) break; if (_sp > XB_SPIN_CAP) { atomicAdd(&(bar)[XB_TMO], 1u); break; } } } } while (0)
struct XcdBarrier { unsigned* bar; unsigned x; volatile LAS unsigned* st; };
__device__ __forceinline__ XcdBarrier xcd_barrier_post(unsigned* bar, volatile LAS unsigned* st) {
    XcdBarrier b; b.bar = bar; b.x = xb_xcc_id(); b.st = st;
    if (threadIdx.x == 0) (void)xb_add(&bar[XB_XCNT(b.x)], 1u);
    return b;
}
__device__ __forceinline__ void xcd_barrier_complete(unsigned* bar, unsigned x, unsigned& nloc, unsigned& nx) {
    const unsigned G = gridDim.x * gridDim.y * gridDim.z;
    unsigned sum, cnt, mine, sp = 0u;
    for (;;) {
        sum = 0u; cnt = 0u; mine = 0u;
#pragma unroll
        for (unsigned j = 0; j < 16; ++j) { const unsigned c = xb_ld(&bar[XB_XCNT(j)]); sum += c; cnt += (c > 0u) ? 1u : 0u; mine = (j == x) ? c : mine; }
        if (sum == G) break;
        __builtin_amdgcn_s_sleep(1);
        if ((++sp & 255u) == 0u) { if (xb_ld(&bar[XB_TMO])) break; if (sp > XB_SPIN_CAP) { atomicAdd(&bar[XB_TMO], 1u); break; } }
    }
    nloc = mine > 0u ? mine : 1u; nx = cnt > 0u ? cnt : 1u;
}
__device__ __forceinline__ void xcd_barrier(const XcdBarrier& b) {
    asm volatile("s_waitcnt vmcnt(0)" ::: "memory");
    __syncthreads();
    if (threadIdx.x == 0) {
        unsigned* bar = b.bar;
        __builtin_amdgcn_s_waitcnt(0);
        unsigned nloc = b.st[0], nx = b.st[1];
        if (nloc == 0u) { xcd_barrier_complete(bar, b.x, nloc, nx); b.st[0] = nloc; b.st[1] = nx; }
        const unsigned old = xb_add(&bar[XB_XSUB(b.x)], 1u);
        const unsigned gen = old / nloc;
        if (old + 1u == (gen + 1u) * nloc) {
            __builtin_amdgcn_fence(__ATOMIC_RELEASE, "agent");
            asm volatile("s_waitcnt vmcnt(0)" ::: "memory");
            const unsigned og = xb_add(&bar[XB_TOP], 1u);
            const unsigned tg = og / nx;
            if (og + 1u == (tg + 1u) * nx) xb_add(&bar[XB_TOPGEN], 1u);
            else XB_SPIN(xb_ld(&bar[XB_TOPGEN]) == tg, bar);
            __builtin_amdgcn_fence(__ATOMIC_ACQUIRE, "agent");
            xb_add(&bar[XB_XGEN(b.x)], 1u);
            asm volatile("s_waitcnt vmcnt(0)" ::: "memory");
        } else {
            XB_SPIN(xb_ld(&bar[XB_XGEN(b.x)]) == gen, bar);
            __builtin_amdgcn_fence(__ATOMIC_ACQUIRE, "agent");
            asm volatile("s_waitcnt vmcnt(0)" ::: "memory");
        }
    }
    __syncthreads();
}

struct Args { const float* in[28]; float* out; unsigned char* ws; int ph_lo, ph_hi, dup, pad; };
enum { I_X = 0, I_MEM, I_NMIXG, I_WIN, I_SGUNG, I_SGUW, I_SGUB, I_QNG, I_KNG, I_LQ1, I_LK1, I_LQ2, I_LK2, I_SUBG, I_RELB, I_WOUT, I_NCG, I_NMG, I_WCQ, I_WCKV, I_CQG, I_CKG, I_WCO, I_NFG, I_PWQ, I_PKEYS, I_PU, I_PV };
constexpr int NPHASE = 11;

template <bool GAIN, bool OUT8 = false> __device__ __forceinline__ void p0_transpose_item(const float* W, int K, int N, bf16_t* WT, LAS float* scr, int item, int lane, const float* gk = nullptr) {
    const int nblk = N / 32, kb = item / nblk, nb = item % nblk, k0 = 64 * kb, n0 = 32 * nb;
#pragma unroll 16
    for (int i = 0; i < 32; ++i) { const int kk = 2 * i + (lane >> 5); scr[kk * 33 + (lane & 31)] = W[(size_t)(k0 + kk) * N + n0 + (lane & 31)]; }
    const int c = lane & 7;
    f32x4 g0 = (f32x4){1.f, 1.f, 1.f, 1.f}, g1 = g0;
    if (GAIN) { g0 = *(const f32x4*)(gk + k0 + 8 * c); g1 = *(const f32x4*)(gk + k0 + 8 * c + 4); }
    asm volatile("s_waitcnt lgkmcnt(0)" ::: "memory");
#pragma unroll
    for (int j = 0; j < 4; ++j) { const int n = (lane >> 3) + 8 * j; const LAS float* s = scr + (8 * c) * 33 + n;
        u32x4 o; o.x = pk2(s[0 * 33] * g0[0], s[1 * 33] * g0[1]); o.y = pk2(s[2 * 33] * g0[2], s[3 * 33] * g0[3]); o.z = pk2(s[4 * 33] * g1[0], s[5 * 33] * g1[1]); o.w = pk2(s[6 * 33] * g1[2], s[7 * 33] * g1[3]);
        if (OUT8) *(u32x2*)((unsigned char*)WT + (size_t)(n0 + n) * K + k0 + 8 * c) = pack8_fp8((f32x4){s[0 * 33] * g0[0], s[1 * 33] * g0[1], s[2 * 33] * g0[2], s[3 * 33] * g0[3]} * W8_SCALE, (f32x4){s[4 * 33] * g1[0], s[5 * 33] * g1[1], s[6 * 33] * g1[2], s[7 * 33] * g1[3]} * W8_SCALE);
        else *(u32x4*)(WT + (size_t)(n0 + n) * K + k0 + 8 * c) = o; }
    asm volatile("s_waitcnt lgkmcnt(0)" ::: "memory");
}
__device__ __forceinline__ void rms_row_to_bf16(const float* xrow, const float* g, bf16_t* orow, int lane, unsigned char* o8row = nullptr) {
    const f32x4* xr = (const f32x4*)xrow + lane; const f32x4* gr = (const f32x4*)g + lane;
    f32x4 v[8]; float s = 0.f;
#pragma unroll
    for (int j = 0; j < 8; ++j) { v[j] = xr[64 * j]; s += (v[j][0] * v[j][0] + v[j][1] * v[j][1]) + (v[j][2] * v[j][2] + v[j][3] * v[j][3]); }
    const float rstd = 1.0f / sqrtf(wave_sum(s) * (1.0f / 2048.0f) + EPS);
    u32x2* o8 = (u32x2*)orow + lane;
#pragma unroll
    for (int j = 0; j < 8; ++j) { const f32x4 gg = gr[64 * j]; const f32x4 y = (f32x4){v[j][0] * rstd * gg[0], v[j][1] * rstd * gg[1], v[j][2] * rstd * gg[2], v[j][3] * rstd * gg[3]};
        if (orow) { u32x2 w; w.x = pk2(y[0], y[1]); w.y = pk2(y[2], y[3]); o8[64 * j] = w; }
        if (o8row) { f32x4 z = y * A8_SCALE;
#pragma unroll
            for (int i = 0; i < 4; ++i) z[i] = __builtin_amdgcn_fmed3f(z[i], -448.0f, 448.0f);
            int b = __builtin_amdgcn_cvt_pk_fp8_f32(z[0], z[1], 0, false); b = __builtin_amdgcn_cvt_pk_fp8_f32(z[2], z[3], b, true);
            ((unsigned*)o8row)[64 * j + lane] = (unsigned)b; } }
}
__device__ __forceinline__ void cvt_chunk(const float* src, bf16_t* dst, size_t chunk, int lane) {
    const f32x4* s = (const f32x4*)(src + chunk * 512) + lane * 2; const f32x4 a = s[0], b = s[1];
    u32x4 w; w.x = pk2(a[0], a[1]); w.y = pk2(a[2], a[3]); w.z = pk2(b[0], b[1]); w.w = pk2(b[2], b[3]);
    *((u32x4*)(dst + chunk * 512) + lane) = w;
}

__device__ __forceinline__ void row_to_fp8(const float* src, unsigned char* T8, float* scl, int e, int lane, const float* gc = nullptr) {
    const f32x4* s0 = (const f32x4*)(src + (size_t)e * 2048 + 16 * lane); const f32x4* s1 = s0 + 256;
    f32x4 v[8]; float m = 0.f;
#pragma unroll
    for (int i = 0; i < 4; ++i) { v[i] = s0[i]; v[4 + i] = s1[i]; }
    if (gc) { const f32x4* g0 = (const f32x4*)(gc + 16 * lane);
#pragma unroll
        for (int i = 0; i < 4; ++i) { v[i] = v[i] * g0[i]; v[4 + i] = v[4 + i] * g0[256 + i]; } }
#pragma unroll
    for (int i = 0; i < 8; ++i) m = fmaxf(fmaxf(m, fmaxf(fabsf(v[i][0]), fabsf(v[i][1]))), fmaxf(fabsf(v[i][2]), fabsf(v[i][3])));
    m = wave_max(m); const float sc = m > 0.f ? 448.0f / m : 1.0f;
#pragma unroll
    for (int hf = 0; hf < 2; ++hf) { u32x4 w;
#pragma unroll
        for (int i = 0; i < 4; ++i) { const f32x4 x = v[hf * 4 + i] * sc; int t = __builtin_amdgcn_cvt_pk_fp8_f32(x[0], x[1], 0, false); t = __builtin_amdgcn_cvt_pk_fp8_f32(x[2], x[3], t, true); w[i] = (unsigned)t; }
        *(u32x4*)(T8 + (size_t)(hf * 8 + (lane >> 3)) * ((size_t)16384 * 128) + (size_t)e * 128 + (lane & 7) * 16) = w; }
    if (lane == 0) scl[e] = m > 0.f ? m * (1.0f / 448.0f) : 1.0f;
}
__device__ __forceinline__ void row_fp4_load(const float* src, int e, int lane, f32x4 (&v)[8]) {
    const f32x4* s0 = (const f32x4*)(src + (size_t)e * 2048) + lane;
#pragma unroll
    for (int i = 0; i < 8; ++i) v[i] = __builtin_nontemporal_load(s0 + 64 * i);
}
__device__ __forceinline__ void row_fp4_store(f32x4 (&v)[8], unsigned char* T4, float* scl, int e, int lane, const float* gc = nullptr) {
    float m = 0.f;
    if (gc) { const f32x4* g0 = (const f32x4*)gc + lane;
#pragma unroll
        for (int i = 0; i < 8; ++i) v[i] = v[i] * g0[64 * i]; }
#pragma unroll
    for (int i = 0; i < 8; ++i) m = fmaxf(fmaxf(m, fmaxf(fabsf(v[i][0]), fabsf(v[i][1]))), fmaxf(fabsf(v[i][2]), fabsf(v[i][3])));
    m = wave_max(m); const float sc = m > 0.f ? 6.0f / m : 1.0f;
#pragma unroll
    for (int i = 0; i < 8; ++i) { unsigned acc = 0u;
        const f32x4 x0 = v[i] * sc;
        acc = __builtin_amdgcn_cvt_scalef32_pk_fp4_f32(acc, x0[0], x0[1], 1.0f, 0); acc = __builtin_amdgcn_cvt_scalef32_pk_fp4_f32(acc, x0[2], x0[3], 1.0f, 1);
        *(unsigned short*)(T4 + (size_t)i * ((size_t)16384 * 128) + (size_t)e * 128 + lane * 2) = (unsigned short)acc; }
    if (lane == 0) scl[e] = m > 0.f ? m * (1.0f / 6.0f) : 1.0f;
}
__device__ __forceinline__ bf16x8 fp4x8_bf16(unsigned d) {
    typedef __bf16 bf16x2_t __attribute__((ext_vector_type(2)));
    u32x4 w; w.x = __builtin_bit_cast(unsigned, __builtin_amdgcn_cvt_scalef32_pk_bf16_fp4(d, 1.0f, 0)); w.y = __builtin_bit_cast(unsigned, __builtin_amdgcn_cvt_scalef32_pk_bf16_fp4(d, 1.0f, 1));
    w.z = __builtin_bit_cast(unsigned, __builtin_amdgcn_cvt_scalef32_pk_bf16_fp4(d, 1.0f, 2)); w.w = __builtin_bit_cast(unsigned, __builtin_amdgcn_cvt_scalef32_pk_bf16_fp4(d, 1.0f, 3));
    return __builtin_bit_cast(bf16x8, w);
}
__device__ __forceinline__ bf16x8 fp8x8_bf16(unsigned d0, unsigned d1) {
    const f32x2 a = __builtin_amdgcn_cvt_pk_f32_fp8((int)d0, false), b = __builtin_amdgcn_cvt_pk_f32_fp8((int)d0, true), c = __builtin_amdgcn_cvt_pk_f32_fp8((int)d1, false), d = __builtin_amdgcn_cvt_pk_f32_fp8((int)d1, true);
    u32x4 w; w.x = cvt_pk_bf16(a.x, a.y); w.y = cvt_pk_bf16(b.x, b.y); w.z = cvt_pk_bf16(c.x, c.y); w.w = cvt_pk_bf16(d.x, d.y);
    return __builtin_bit_cast(bf16x8, w);
}

__device__ __forceinline__ int t5_bucket(int n) {
    if (n < 16) return n;
    int b = 16;
    b += (n >= 19); b += (n >= 21); b += (n >= 24); b += (n >= 27); b += (n >= 31); b += (n >= 35); b += (n >= 40); b += (n >= 46);
    b += (n >= 52); b += (n >= 59); b += (n >= 67); b += (n >= 77); b += (n >= 87); b += (n >= 99); b += (n >= 113);
    return b;
}

__device__ __forceinline__ int fresh_lane() { unsigned l; asm volatile("v_mbcnt_lo_u32_b32 %0, -1, 0\n\tv_mbcnt_hi_u32_b32 %0, -1, %0" : "=v"(l)); return (int)l; }
__device__ __forceinline__ void glds16(const void* gsrc, unsigned lds_dst) { unsigned keep;
    asm volatile("s_mov_b32 %0, m0\n\ts_mov_b32 m0, %2\n\ts_nop 0\n\tglobal_load_lds_dwordx4 %1, off\n\ts_mov_b32 m0, %0" : "=&s"(keep) : "v"(gsrc), "s"(lds_dst) : "memory"); }
__device__ __forceinline__ int f2s(float f) { int s = __builtin_bit_cast(int, f); return s ^ ((s >> 31) & 0x7fffffff); }
__device__ __forceinline__ float s2f(int s) { return __builtin_bit_cast(float, s ^ ((s >> 31) & 0x7fffffff)); }
#define INS16(L, vv) do { int _v = (vv); _Pragma("unroll") for (int _j = 0; _j < 16; ++_j) { const int _h = max(L[_j], _v); _v = min(L[_j], _v); L[_j] = _h; } } while (0)

#define CEX(L, i_, j_) do { const int _a = max(L[i_], L[j_]), _b = min(L[i_], L[j_]); L[i_] = _a; L[j_] = _b; } while (0)
__device__ __forceinline__ void bitonic_sort16(int (&L)[16]) {
#pragma unroll
    for (int k = 2; k <= 16; k <<= 1)
#pragma unroll
        for (int j = k >> 1; j >= 1; j >>= 1)
#pragma unroll
            for (int i = 0; i < 16; ++i) { const int l = i ^ j; if (l > i) { if ((i & k) == 0) CEX(L, i, l); else CEX(L, l, i); } }
}
__device__ __forceinline__ void merge_top16(int (&L)[16], const int (&N)[16]) {
#pragma unroll
    for (int i = 0; i < 16; ++i) L[i] = max(L[i], N[15 - i]);
#pragma unroll
    for (int d = 8; d >= 1; d >>= 1)
#pragma unroll
        for (int i = 0; i < 16; ++i) if ((i & d) == 0) CEX(L, i, i + d);
}
__device__ __forceinline__ void peer_top16(const bf16_t* qp, const bf16_t* kp, int hh, int (&L)[16]) {
#pragma unroll
    for (int i = 0; i < 16; ++i) L[i] = (int)0x80000000;
#pragma unroll 1
    for (int kt = 0; kt < 4; ++kt) {
        f32x16 sc = (f32x16){};
#pragma unroll
        for (int k0 = 0; k0 < 8; ++k0) { const bf16x8 af = *(const bf16x8*)(kp + (size_t)kt * 32 * 128 + 16 * k0); const bf16x8 bq = *(const bf16x8*)(qp + 16 * k0); sc = __builtin_amdgcn_mfma_f32_32x32x16_bf16(af, bq, sc, 0, 0, 0); }
        const int kbase = 32 * kt + 4 * hh;
        int N[16];
#pragma unroll
        for (int r = 0; r < 16; ++r) N[r] = (f2s(sc[r]) & ~0x7f) | (kbase + (r & 3) + 8 * (r >> 2));
        bitonic_sort16(N);
        merge_top16(L, N);
    }
    int m[16];
#pragma unroll
    for (int i = 0; i < 16; ++i) { auto rr = __builtin_amdgcn_permlane32_swap((unsigned)L[i], (unsigned)L[i], false, false); m[i] = hh ? (int)rr[0] : (int)rr[1]; }
    merge_top16(L, m);
}

template <int VAR3, int VAR10 = 0> __global__ void __launch_bounds__(512, 2) fwd_t(Args args) {
    extern __shared__ __attribute__((aligned(16))) unsigned char lds_raw[];
    LAS unsigned char* lds = (LAS unsigned char*)lds_raw;
    volatile LAS unsigned* MISC = (volatile LAS unsigned*)(lds + MISC_OFF);
    const int tid = threadIdx.x, lane = tid & 63, wave = __builtin_amdgcn_readfirstlane(tid >> 6);
    const int G = gridDim.x, bx = blockIdx.x, vcu = (G % 8 == 0) ? (bx % 8) * (G / 8) + bx / 8 : bx;
    unsigned char* ws = args.ws;
    unsigned* ctl = (unsigned*)(ws + WS_CTL);
    for (int u = tid; u < (LDS_BYTES - RING_BYTES) / 4; u += 512) ((LAS unsigned*)(lds + RING_BYTES))[u] = 0u;
    __syncthreads();
#if MK_SPLIT
#define GRID_BAR() do { } while (0)
#else
    XcdBarrier bar = xcd_barrier_post(ctl + CW_BAR, MISC + 8);
#define GRID_BAR() xcd_barrier(bar)
#endif
    const int lo = args.ph_lo, hi = args.ph_hi;
#ifdef ONLY_PHASE
#define IN(k) ((k) == ONLY_PHASE)
#else
#define IN(k) ((VAR10 == 0 || (k) == 10) && (VAR3 == 0 || (k) == 3) && lo <= (k) && (k) < hi)
#endif
#define SEAM(k) do { if (IN(k) && IN((k) + 1)) GRID_BAR(); } while (0)

    bf16_t* WIN = (bf16_t*)(ws + WS_WIN); bf16_t* WOUT = (bf16_t*)(ws + WS_WOUT); bf16_t* WCQ = (bf16_t*)(ws + WS_WCQ); bf16_t* WCKV = (bf16_t*)(ws + WS_WCKV);
    bf16_t* WCO = (bf16_t*)(ws + WS_WCO); bf16_t* WPQ = (bf16_t*)(ws + WS_WPQ); bf16_t* KEYS = (bf16_t*)(ws + WS_KEYS); bf16_t* SGUW = (bf16_t*)(ws + WS_SGUW);
    float* KGQG = (float*)(ws + WS_MISC);
    bf16_t* MEMN = (bf16_t*)(ws + WS_MEMN); bf16_t* KC = (bf16_t*)(ws + WS_KC); bf16_t* VCT = (bf16_t*)(ws + WS_VCT); float* LPART = (float*)(ws + WS_LPART);
    bf16_t* XN = (bf16_t*)(ws + WS_XN); bf16_t* Z = (bf16_t*)(ws + WS_Z); bf16_t* QC = (bf16_t*)(ws + WS_QC); bf16_t* PC = (bf16_t*)(ws + WS_PC); bf16_t* QP = (bf16_t*)(ws + WS_QP);
    bf16_t* VT = (bf16_t*)(ws + WS_VT); bf16_t* MIX = (bf16_t*)(ws + WS_MIX);
    u64* SSQ1 = (u64*)(ws + CB_SSQ1); u64* SSQ2 = (u64*)(ws + CB_SSQ2); u64* SSQK = (u64*)(ws + CB_SSQK); u64* SSQQ = (u64*)(ws + CB_SSQQ);
#if MK_SPLIT
    const bool dup = args.dup != 0;
    u64* SSQ1w = dup ? (u64*)(ws + WS_MISC + 65536) : SSQ1; u64* SSQ2w = dup ? (u64*)(ws + WS_MISC + 65536) : SSQ2; u64* SSQKw = dup ? (u64*)(ws + WS_MISC + 65536) : SSQK; u64* SSQQw = dup ? (u64*)(ws + WS_MISC + 65536) : SSQQ;
    const float dupscale = dup ? 0.f : 1.f; bf16_t* QKNW = dup ? XN : Z + 2048; const int qknld = dup ? 2048 : 4096;
#else
    u64* SSQ1w = SSQ1; u64* SSQ2w = SSQ2; u64* SSQKw = SSQK; u64* SSQQw = SSQQ; const float dupscale = 1.f; bf16_t* QKNW = Z + 2048; const int qknld = 4096;
#endif
#define P10SCALE ((VAR10 != 0) ? 0.0f : 1.0f)
#define P10STORE (VAR10 == 0)
    const int gw = vcu * 8 + wave, NGW = G * 8;

    if (IN(0)) {
        LAS float* scr = (LAS float*)(lds + wave * 16384);
        constexpr int I_IN = 32 * (5120 / 32), I_SQ = 32 * (2048 / 32), I_KV = 32 * (4096 / 32);
        constexpr int NIT = I_IN + 4 * I_SQ + I_KV;
        for (int it = gw; it < NIT; it += NGW) {
            int r = it;
            if (r < I_IN) { if (r % (5120 / 32) < 2048 / 32) p0_transpose_item<false, true>(args.in[I_WIN], 2048, 5120, WIN, scr, r, lane);
                            else p0_transpose_item<false>(args.in[I_WIN], 2048, 5120, WIN, scr, r, lane); continue; } r -= I_IN;
            if (r < I_SQ) { p0_transpose_item<false>(args.in[I_WOUT], 2048, 2048, WOUT, scr, r, lane); continue; } r -= I_SQ;
            if (r < I_SQ) { p0_transpose_item<true, true>(args.in[I_WCQ], 2048, 2048, WCQ, scr, r, lane, args.in[I_NCG]); continue; } r -= I_SQ;
            if (r < I_KV) { p0_transpose_item<false, true>(args.in[I_WCKV], 2048, 4096, WCKV, scr, r, lane); continue; } r -= I_KV;
            if (r < I_SQ) { p0_transpose_item<false, true>(args.in[I_WCO], 2048, 2048, WCO, scr, r, lane); continue; } r -= I_SQ;
            p0_transpose_item<true>(args.in[I_PWQ], 2048, 2048, WPQ, scr, r, lane, args.in[I_NFG]);
        }
        for (int m = gw; m < T; m += NGW) rms_row_to_bf16(args.in[I_X] + (size_t)m * D, args.in[I_NMIXG], XN + (size_t)m * D, lane, ws + WS_MIX + (size_t)m * D);
        for (int m = gw; m < MROWS; m += NGW) rms_row_to_bf16(args.in[I_MEM] + (size_t)m * D, args.in[I_NMG], nullptr, lane, (unsigned char*)MEMN + (size_t)m * D);
        for (int c = gw; c < 262144 / 512; c += NGW) cvt_chunk(args.in[I_PKEYS], KEYS, c, lane);
        { f32x4 ua[8], va[8];
          if (gw < 16384) { row_fp4_load(args.in[I_PU], gw, lane, ua); row_fp4_load(args.in[I_PV], gw, lane, va); }
          for (int e = gw; e < 16384; e += NGW) { f32x4 ub[8], vb[8]; const int en = (e + NGW < 16384) ? e + NGW : e;
              row_fp4_load(args.in[I_PU], en, lane, ub); row_fp4_load(args.in[I_PV], en, lane, vb);
              row_fp4_store(ua, ws + WS_U8, (float*)(ws + WS_USC), e, lane, args.in[I_NFG]); row_fp4_store(va, ws + WS_V8, (float*)(ws + WS_VSC), e, lane);
#pragma unroll
              for (int i = 0; i < 8; ++i) { ua[i] = ub[i]; va[i] = vb[i]; } } }
        for (int i = gw * 64 + lane; i < 8 * 128 * 128; i += NGW * 64) { const int p = (i >> 7) & 127, q = i & 127; SGUW[i] = (bf16_t)f2bf(q <= p ? args.in[I_SGUW][i] : 0.f); }
        if (bx == 0) { const float v = args.in[I_CKG][tid] * args.in[I_CQG][tid]; KGQG[tid] = v; }
    }
    SEAM(0);

    if (IN(1)) {
        { pg8::Gemm g{D / 2, D / 2, D / 2}; pg8::PlainOrder S; S.init(ws + WS_MIX, WIN, D / 2, D / 2, T, 2048, G, bx);
          pg8::EpiB<true, false, false, false> E{Z, 4096, 8, nullptr, 0, nullptr, 0.f, nullptr, 0, 1, 1.0f / (A8_SCALE * W8_SCALE)};
          pg8::gemm_phase<true>(lds, g, S, E); }
        { pg8::Gemm g{D, D, D}; pg8::PlainOrder S; S.init(XN, WIN + (size_t)2048 * D, D, D, T, 2048, G, bx);
          pg8::EpiQK E{Z + 2048, 4096, args.in[I_QNG], args.in[I_KNG], (LAS float*)(lds + RING_BYTES + 4096)};
          pg8::gemm_phase(lds, g, S, E); }
        { pg8::Gemm g{D, D, D}; pg8::PlainOrder S; S.init(WIN + (size_t)4096 * D, XN, D, D, 1024, T, G, bx);
          pg8::EpiB<false, false, false, false> E{VT, T, 0, nullptr, 0, nullptr, 0.f, nullptr, 0, 1};
          pg8::gemm_phase(lds, g, S, E); }
    }
    SEAM(1);

    if (IN(2)) {
        constexpr int VROW = 136;
        LAS bf16_t* vnT = (LAS bf16_t*)lds;
        const float* sgu_g = args.in[I_SGUNG]; const float* sgu_b = args.in[I_SGUB];
        LAS float* const sgl = (LAS float*)(lds + RING_BYTES + 8192);
        { const float2 gv = *(const float2*)(args.in[I_SGUNG] + 2 * tid); sgl[2 * tid] = gv.x; sgl[2 * tid + 1] = gv.y; }
        const bool kvsplit = (G == 256); const bool kvcu = kvsplit && vcu < 64;
        const int sv = kvsplit ? vcu - 64 : vcu, SG = kvsplit ? G - 64 : G;
        if (kvcu || !kvsplit) { pg8::Gemm g{D / 2, D / 2, D / 2};
          pg8::PairOrder S{(const char*)MEMN, (const char*)WCKV, (const char*)WCKV + (size_t)2048 * D, (const char*)MEMN, D / 2, D / 2, MROWS / 256, 2048 / 256, 2048 / 256, MROWS / 256, kvsplit ? 64 : G, vcu};
          pg8::EpiKV E{KC, VCT, KGQG, SSQKw, 1.0f / (A8_SCALE * W8_SCALE)};
          pg8::gemm_phase<true>(lds, g, S, E); }
        unsigned qn = 0u;
        if (tid == 0) MISC[16] = atomicAdd(ctl + CW_SGUQ, 1u);
        for (;;) {
            __syncthreads();
            const int uidx = (int)MISC[16];
            if (uidx >= 1024) break;
            const int b = uidx >> 8, n = (uidx >> 3) & 31, h = uidx & 7; const size_t t0 = (size_t)b * SEQ + n * 128;
            { const int p = tid >> 2, part = tid & 3; const bf16_t* vp = Z + (t0 + p) * 4096 + 1024 + h * 128 + part * 32;
              u32x4 raw[4]; float f[32]; float s = 0.f;
#pragma unroll
              for (int i = 0; i < 4; ++i) raw[i] = *(const u32x4*)(vp + i * 8);
              if (tid == 0) qn = atomicAdd(ctl + CW_SGUQ, 1u);
#pragma unroll
              for (int i = 0; i < 4; ++i)
#pragma unroll
                  for (int e = 0; e < 4; ++e) { f[i * 8 + 2 * e] = bflo(raw[i][e]); f[i * 8 + 2 * e + 1] = bfhi(raw[i][e]); }
#pragma unroll
              for (int i = 0; i < 32; ++i) s += f[i] * f[i];
              s = quad_sum(s);
              const float rstd = 1.0f / sqrtf(s * (1.0f / 128.0f) + EPS);
#pragma unroll
              for (int i = 0; i < 32; ++i) { const int c = part * 32 + i; vnT[c * VROW + p] = (bf16_t)f2bf(f[i] * rstd * sgl[h * 128 + c]); }
            }
            __syncthreads();
            { const int wp = wave & 3, wcc = wave >> 2, j = lane & 31, hh = lane >> 5;
              f32x16 acc[2]; acc[0] = (f32x16){}; acc[1] = (f32x16){};
              const bf16_t* wrow = SGUW + ((size_t)h * 128 + 32 * wp + j) * 128 + 8 * hh;
              bf16x8 bfrv[8];
#pragma unroll
              for (int ks = 0; ks < 8; ++ks) if (ks <= 2 * wp + 1) bfrv[ks] = *(const bf16x8*)(wrow + 16 * ks);
#pragma unroll
              for (int ks = 0; ks < 8; ++ks) if (ks <= 2 * wp + 1) {
#pragma unroll
                  for (int ct = 0; ct < 2; ++ct) { const bf16x8 afr = *(const LAS bf16x8*)(vnT + (64 * wcc + 32 * ct + j) * VROW + 16 * ks + 8 * hh);
                      acc[ct] = __builtin_amdgcn_mfma_f32_32x32x16_bf16(afr, bfrv[ks], acc[ct], 0, 0, 0); }
              }
              const int p = 32 * wp + j; const float bs = sgu_b[h * 128 + p]; const size_t tok = t0 + p;
#pragma unroll
              for (int ct = 0; ct < 2; ++ct)
#pragma unroll
                  for (int ga = 0; ga < 2; ++ga) {
                      const int cb = 64 * wcc + 32 * ct + 16 * ga + 8 * hh;
                      const u32x4 L = *(const u32x4*)(Z + tok * 4096 + h * 128 + cb);
                      const auto lx = __builtin_amdgcn_permlane32_swap(L.x, L.z, false, false), ly = __builtin_amdgcn_permlane32_swap(L.y, L.w, false, false);
                      u32x2 wv[2];
#pragma unroll
                      for (int k = 0; k < 2; ++k) { const int g4 = 2 * ga + k; const unsigned ux = lx[k], uy = ly[k];
                          const float o0 = bflo(ux) * (acc[ct][4 * g4 + 0] + bs), o1 = bfhi(ux) * (acc[ct][4 * g4 + 1] + bs), o2 = bflo(uy) * (acc[ct][4 * g4 + 2] + bs), o3 = bfhi(uy) * (acc[ct][4 * g4 + 3] + bs);
                          wv[k].x = pk2(o0, o1); wv[k].y = pk2(o2, o3); }
                      const auto rx = __builtin_amdgcn_permlane32_swap(wv[0].x, wv[1].x, false, false), ry = __builtin_amdgcn_permlane32_swap(wv[0].y, wv[1].y, false, false);
                      *(u32x4*)(MIX + tok * D + h * 128 + cb) = (u32x4){rx[0], ry[0], rx[1], ry[1]}; }
            }
            if (tid == 0) MISC[16] = qn;
        }
    }
    __syncthreads();

    if (IN(3)) {
        constexpr int STG = 32768;
        constexpr int var3 = VAR3; bf16_t* AOUT = (VAR3 != 0) ? XN : MIX;
        LAS float* tab = (LAS float*)(lds + RING_BYTES + 1024);
        const float* relb = args.in[I_RELB];
        const int j = lane & 31, hh = lane >> 5, w = wave, g = w & 3, c = w >> 2;
        const int pi = (j & ~12) | ((j & 4) << 1) | ((j & 8) >> 1);
        int koff[4], voff[4];
#pragma unroll
        for (int d0 = 0; d0 < 4; ++d0) { koff[d0] = c * 8192 + pi * 128 + (((2 * d0 + hh) ^ ((pi >> 1) & 7)) << 4); voff[d0] = 16384 + j * 128 + (((2 * d0 + hh) ^ ((j >> 1) & 7)) << 4); }
        const int bh = vcu >> 3, sidx = vcu & 7, b = bh >> 3, h = bh & 7;
        const unsigned lds0 = (unsigned)(size_t)lds;
        if (bh < 32) {
        __syncthreads();
        if (tid < 128) { tab[tid] = relb[t5_bucket(tid) * 8 + h] * LOG2E; tab[160 + tid] = args.in[I_SUBG][tid]; }
        if (wave == 2) {
            const float a1 = wave_sum(args.in[I_LQ1][lane] * args.in[I_LK1][lane]), a2 = wave_sum(args.in[I_LQ2][lane] * args.in[I_LK2][lane]);
            const float gqm = wave_max(fabsf(args.in[I_QNG][lane])), gkm = wave_max(fabsf(args.in[I_KNG][lane]));
            const float bmax = wave_max(lane < 32 ? relb[lane * 8 + h] : -1e30f);
            const float M2 = LOG2E * (8.0f * gqm * gkm + bmax);
            const float B31 = relb[31 * 8 + h] * LOG2E; const bool needshift = (M2 - B31) > 60.0f; const float SH = needshift ? M2 : B31;
            if (lane == 0) { tab[128] = -SH; tab[129] = B31 - SH; tab[130] = expf(a1) - expf(a2) + 0.2f; tab[131] = needshift ? 1.0f : 0.0f; }
        }
        __syncthreads();
        const float c_near = tab[128], c_far = tab[129], lam = tab[130]; const bool needshift = tab[131] != 0.f;
        const size_t tokbase = (size_t)b * SEQ;
        if (wave >= 4) __builtin_amdgcn_s_setprio(1);
        for (int ui = 0; ui < 4; ++ui) {
            const int qb = ui == 0 ? 31 - sidx : (ui == 1 ? 16 + sidx : (ui == 2 ? 15 - sidx : sidx));
            const int q0 = qb * 128, NT = (q0 + 128) / 64, my_last = qb * 2 + (g >> 1);
            const int qpos = q0 + 32 * g + j;
            bf16x8 Q[4];
            { const bf16_t* qrow = Z + (tokbase + qpos) * 4096 + 2048 + h * 128 + c * 64 + hh * 8;
#pragma unroll
              for (int d0 = 0; d0 < 4; ++d0) Q[d0] = *(const bf16x8*)(qrow + d0 * 16); }
            const int krow = 8 * w + (lane >> 3), kgr = (lane & 7) ^ ((krow >> 1) & 7);
            const int vd0 = 16 * w + (lane >> 3), vd1 = vd0 + 8;
            const unsigned kvo = (unsigned)(krow * 4096 + kgr * 8) * 2u;
            const unsigned vvo0 = (unsigned)(vd0 * T + ((lane & 7) ^ ((vd0 >> 1) & 7)) * 8) * 2u, vvo1 = (unsigned)(vd1 * T + ((lane & 7) ^ ((vd1 >> 1) & 7)) * 8) * 2u;
            const bf16_t* const kb0 = Z + tokbase * 4096 + 3072 + h * 128; const bf16_t* const vb0 = VT + (size_t)(h * 128) * T + tokbase;
#define DA_ISSUE(t_, st_) do { const bf16_t* kb_ = kb0 + (size_t)(t_) * 64 * 4096; const bf16_t* vb_ = vb0 + (t_) * 64; \
            const unsigned sb_ = (unsigned)__builtin_amdgcn_readfirstlane((int)(lds0 + (unsigned)(st_) * STG + (unsigned)w * 1024u)); \
            const unsigned sv_ = (unsigned)__builtin_amdgcn_readfirstlane((int)(lds0 + (unsigned)(st_) * STG + 16384u + (unsigned)w * 2048u)); \
            glds16s((const void*)kb_, kvo, sb_); glds16s((const void*)(kb_ + 64), kvo, sb_ + 8192u); \
            glds16s((const void*)vb_, vvo0, sv_); glds16s((const void*)vb_, vvo1, sv_ + 1024u); } while (0)
            f32x16 O[4];
#pragma unroll
            for (int dt = 0; dt < 4; ++dt) O[dt] = (f32x16){};
            float lsum = 0.f;
            bf16x8 P[4];
#pragma unroll
            for (int i = 0; i < 4; ++i) P[i] = (bf16x8){0, 0, 0, 0, 0, 0, 0, 0};
#define DA_LDK(kb_) do { _Pragma("unroll") for (int d0 = 0; d0 < 4; ++d0) { kf[2 * d0] = *(const LAS bf16x8*)((kb_) + koff[d0]); kf[2 * d0 + 1] = *(const LAS bf16x8*)((kb_) + 4096 + koff[d0]); } } while (0)
#define DA_LDVG(BUF, kb_, ks_) do { _Pragma("unroll") for (int dt = 0; dt < 4; ++dt) BUF[dt] = *(const LAS bf16x8*)((kb_) + dt * 4096 + voff[ks_]); } while (0)
#define DA_S(ci_) do { if (needshift) { _Pragma("unroll") for (int r = 0; r < 16; ++r) S0[r] = (ci_); \
                    S1 = __builtin_amdgcn_mfma_f32_32x32x16_bf16(kf[1], Q[0], S0, 0, 0, 0); S0 = __builtin_amdgcn_mfma_f32_32x32x16_bf16(kf[0], Q[0], S0, 0, 0, 0); }     \
                else { S0 = __builtin_amdgcn_mfma_f32_32x32x16_bf16(kf[0], Q[0], (f32x16){}, 0, 0, 0); S1 = __builtin_amdgcn_mfma_f32_32x32x16_bf16(kf[1], Q[0], (f32x16){}, 0, 0, 0); } \
                _Pragma("unroll") for (int d0 = 1; d0 < 4; ++d0) { S0 = __builtin_amdgcn_mfma_f32_32x32x16_bf16(kf[2 * d0], Q[d0], S0, 0, 0, 0); S1 = __builtin_amdgcn_mfma_f32_32x32x16_bf16(kf[2 * d0 + 1], Q[d0], S1, 0, 0, 0); } } while (0)
#define DA_BIAS(key0_) do {                                            \
                _Pragma("unroll") for (int q8 = 0; q8 < 4; ++q8) { float tv_[8]; const int dtop_ = qpos - ((key0_) + 32 * (q8 >> 1) + 16 * (q8 & 1) + 8 * hh);     \
                    _Pragma("unroll") for (int e = 0; e < 8; ++e) { const int d_ = dtop_ - e; tv_[e] = tab[d_ < 0 ? 0 : (d_ > 127 ? 127 : d_)]; } \
                    _Pragma("unroll") for (int e = 0; e < 8; ++e) { const int d_ = dtop_ - e; const int r_ = 8 * (q8 & 1) + e; \
                        if (q8 < 2) { const float a_ = S0[r_] + (tv_[e] + dnear); S0[r_] = d_ < 0 ? -INFINITY : a_; } else { const float a_ = S1[r_] + (tv_[e] + dnear); S1[r_] = d_ < 0 ? -INFINITY : a_; } } \
                    __builtin_amdgcn_sched_barrier(0); } } while (0)
#define DA_SX(n_) (((n_) < 16) ? S0[(n_) & 15] : S1[(n_) & 15])
#define DA_EXP2(i_) do { const float e0_ = __builtin_amdgcn_exp2f(DA_SX(2 * (i_))), e1_ = __builtin_amdgcn_exp2f(DA_SX(2 * (i_) + 1)); lsum += e0_; lsum += e1_; PW[i_] = __builtin_bit_cast(unsigned, __builtin_convertvector((f32x2){e0_, e1_}, da_bf16x2_t)); } while (0)
#define DA_PACK() do { P[0] = __builtin_bit_cast(bf16x8, (u32x4){PW[0], PW[1], PW[2], PW[3]}); P[1] = __builtin_bit_cast(bf16x8, (u32x4){PW[4], PW[5], PW[6], PW[7]}); \
                P[2] = __builtin_bit_cast(bf16x8, (u32x4){PW[8], PW[9], PW[10], PW[11]}); P[3] = __builtin_bit_cast(bf16x8, (u32x4){PW[12], PW[13], PW[14], PW[15]}); } while (0)
#define DA_PVX(kb_, SM) do { bf16x8 va[4], vb[4]; DA_LDVG(va, kb_, 0); \
                _Pragma("unroll") for (int k = 0; k < 4; ++k) { \
                    if (k == 0) DA_LDVG(vb, kb_, 1); else if (k == 1) DA_LDVG(va, kb_, 2); else if (k == 2) DA_LDVG(vb, kb_, 3); \
                    _Pragma("unroll") for (int dt = 0; dt < 4; ++dt) { \
                        O[dt] = __builtin_amdgcn_mfma_f32_32x32x16_bf16((k & 1) ? vb[dt] : va[dt], P[k], O[dt], 0, 0, 0); \
                        if (SM) DA_EXP2(4 * k + dt); \
                        __builtin_amdgcn_sched_barrier(0); } } } while (0)
#define DA_SYNC(t_) do { if ((t_) + 2 < NT) asm volatile("s_waitcnt vmcnt(4)" ::: "memory"); else asm volatile("s_waitcnt vmcnt(0)" ::: "memory");     \
                __builtin_amdgcn_s_barrier();                               \
                asm volatile("" ::: "memory"); \
                if ((t_) + 3 < NT) DA_ISSUE((t_) + 3, ((t_) + 3) & 3); } while (0)
            DA_ISSUE(0, 0); DA_ISSUE(1, 1);
            if (2 < NT) DA_ISSUE(2, 2);
            typedef __bf16 da_bf16x2_t __attribute__((ext_vector_type(2)));
            unsigned PW[16];
            const float dnear = c_near - c_far;
            { f32x16 S0, S1; bf16x8 kf[8];
              DA_SYNC(0);
              { const bool far = (63 + 113 <= q0 + 32 * g);
                DA_LDK(lds); __builtin_amdgcn_sched_barrier(0);
                DA_S(c_far);
                if (!far) DA_BIAS(0);
#pragma unroll
                for (int i = 0; i < 16; ++i) DA_EXP2(i);
                DA_PACK(); }
              for (int t = 0; t < NT; ++t) {
                  if (t > 0) DA_SYNC(t);
                  if (t <= my_last) {
                      const LAS unsigned char* kbv = lds + (t & 3) * STG;
                      if (t + 1 <= my_last) {
                          const LAS unsigned char* kbk = lds + ((t + 1) & 3) * STG; const int key0 = (t + 1) * 64;
                          const bool far = (key0 + 63 + 113 <= q0 + 32 * g);
                          DA_LDK(kbk); __builtin_amdgcn_sched_barrier(0);
                          DA_S(c_far);
                          if (!far) DA_BIAS(key0);
                          __builtin_amdgcn_sched_barrier(0);
                          DA_PVX(kbv, true);
                          DA_PACK();
                      } else { DA_PVX(kbv, false); }
                  }
              }
            }
#undef DA_SYNC
#undef DA_LDK
#undef DA_LDVG
#undef DA_S
#undef DA_BIAS
#undef DA_SX
#undef DA_EXP2
#undef DA_PACK
#undef DA_PVX
            { auto r1 = __builtin_amdgcn_permlane32_swap(__float_as_uint(lsum), __float_as_uint(lsum), false, false); lsum = __uint_as_float(r1[0]) + __uint_as_float(r1[1]); }
            __syncthreads();
            LAS float* xch = (LAS float*)(lds + g * 16384) + lane;
            if (c == 1) { const float i2 = lam / lsum;
#pragma unroll
                for (int dt = 0; dt < 4; ++dt)
#pragma unroll
                    for (int r = 0; r < 16; ++r) xch[(dt * 16 + r) * 64] = O[dt][r] * i2; }
            __syncthreads();
            if (c == 0) { const float i1 = 1.0f / lsum; float ss = 0.f;
#pragma unroll
                for (int dt = 0; dt < 4; ++dt)
#pragma unroll
                    for (int r = 0; r < 16; ++r) { const float o = O[dt][r] * i1 - xch[(dt * 16 + r) * 64]; O[dt][r] = o; ss += o * o; }
                auto r3 = __builtin_amdgcn_permlane32_swap(__float_as_uint(ss), __float_as_uint(ss), false, false); ss = __uint_as_float(r3[0]) + __uint_as_float(r3[1]);
                const float rstd = 0.8f / sqrtf(ss * (1.0f / 128.0f) + EPS);
                const float* sg = args.in[I_SUBG]; bf16_t* orow = AOUT + (tokbase + qpos) * D + 1024 + h * 128;
#pragma unroll
                for (int dt = 0; dt < 4; ++dt)
#pragma unroll
                    for (int ga = 0; ga < 2; ++ga) {
                        u32x2 wv[2];
#pragma unroll
                        for (int k = 0; k < 2; ++k) { const int g4 = 2 * ga + k; const int d = 32 * dt + 8 * g4 + 4 * hh; const f32x4 gg = *(const LAS f32x4*)(tab + 160 + d);
                            wv[k].x = cvt_pk_bf16(O[dt][4 * g4] * rstd * gg[0], O[dt][4 * g4 + 1] * rstd * gg[1]); wv[k].y = cvt_pk_bf16(O[dt][4 * g4 + 2] * rstd * gg[2], O[dt][4 * g4 + 3] * rstd * gg[3]); }
                        const auto rx = __builtin_amdgcn_permlane32_swap(wv[0].x, wv[1].x, false, false), ry = __builtin_amdgcn_permlane32_swap(wv[0].y, wv[1].y, false, false);
                        *(u32x4*)(orow + 32 * dt + 16 * ga + 8 * hh) = (u32x4){rx[0], ry[0], rx[1], ry[1]}; }
            }
            __syncthreads();
        }
        }
#undef DA_ISSUE
        __builtin_amdgcn_s_setprio(0);
    }
    SEAM(3);

    if (IN(4)) {
        pg8::Gemm g{D, D, D}; pg8::PlainOrder S; S.init(MIX, WOUT, D, D, T, D, G, bx);
        pg8::EpiH<true> E{args.in[I_X], XN, SSQ1w, ws + WS_H8, 1.f};
        pg8::gemm_phase(lds, g, S, E);
    }
    SEAM(4);

    if (IN(5)) {
        pg8::Gemm g{D / 2, D / 2, D / 2}; pg8::ChainOrder<5> S{(const char*)(ws + WS_H8), (const char*)WCQ, D / 2, D / 2, G, vcu, 0, 0, 0, 0};
        pg8::EpiB<false, false, false, true> E{QC, D, 0, nullptr, 0, nullptr, 0.f, SSQQw, 4, 2, 1.0f / (A8_SCALE * W8_SCALE)};
        pg8::gemm_phase<true>(lds, g, S, E);
    }
    __syncthreads();

    if (IN(6)) {
        __syncthreads();
        if (wave == 0) { float a = 0.f, c = 0.f;
            for (int i = lane; i < 512; i += 64) { a = fmaxf(a, fabsf(args.in[I_CQG][i])); c = fmaxf(c, fabsf(args.in[I_CKG][i])); }
            a = wave_max(a); c = wave_max(c); if (lane == 0) ((LAS float*)(lds + RING_BYTES))[16] = 22.627416998f * a * c * LOG2E; }
        __syncthreads();
        const float cshift = ((LAS float*)(lds + RING_BYTES))[16];
        pg8::Gemm g{D, D, 512};
        pg8::BatchOrder S{(const char*)QC, (const char*)KC, D, D, 16, 1, 256, G, vcu, (size_t)SEQ * D * 2, 512 * 2, (size_t)MEML * D * 2, 512 * 2};
        pg8::EpiS E{PC, SSQ1, SSQQ, SSQK, LPART, cshift};
        pg8::gemm_phase(lds, g, S, E);
    }
    __syncthreads();

    if (IN(7)) {
        pg8::Gemm g{1024, MROWS, 256};
        pg8::ChainOrder<7> S{(const char*)PC, (const char*)VCT, 1024, MROWS, G, vcu, (size_t)SEQ * 1024 * 2, 256 * 2, 256 * 2, (size_t)512 * MROWS * 2};
        pg8::EpiPV E{(unsigned char*)MIX, LPART};
        pg8::gemm_phase(lds, g, S, E);
    }
    SEAM(7);

    if (IN(8)) {
        pg8::Gemm g{D / 2, D / 2, D / 2}; pg8::PlainOrder S; S.init(MIX, WCO, D / 2, D / 2, T, D, G, bx);
        pg8::EpiH<false> E{XN, XN, SSQ2w, nullptr, dupscale * (1.0f / (OC8_SCALE * W8_SCALE))};
        pg8::gemm_phase<true>(lds, g, S, E);
    }
    SEAM(8);

    if (IN(9)) {
        pg8::Gemm g{D, D, D}; pg8::PlainOrder S; S.init(XN, WPQ, D, D, T, D, G, bx);
        pg8::EpiB<false, false, true, false> E{QP, D, 0, nullptr, 0, SSQ2, 1.0f / 2048.0f, nullptr, 0, 1};
        pg8::gemm_phase(lds, g, S, E);
    }
    SEAM(9);

    if (IN(10)) {
        constexpr size_t SLICE = (size_t)16384 * 128;
        LAS unsigned short* PIDX = (LAS unsigned short*)lds;
        LAS float* PGT = (LAS float*)(lds + 16384);
        LAS float* AACC = (LAS float*)(lds + 49152);
        LAS unsigned char* KSEL = lds + 81920;
        const unsigned char* U8 = ws + WS_U8; const unsigned char* V8 = ws + WS_V8; const float* USC = (const float*)(ws + WS_USC); const float* VSC = (const float*)(ws + WS_VSC);
        const int j = lane & 31, hh = lane >> 5;
        const int xcc = (int)xb_xcc_id();
        for (int tb = vcu; tb < T / 64; tb += G) {
            const int tok0 = tb * 64;
            __syncthreads();
            constexpr int sub = (VAR10 == 4) ? 0 : VAR10;
            if (sub >= 2) { for (int i = tid; i < 8192; i += 512) { PIDX[i] = (unsigned short)((i * 2654435761u >> 7) & 16383u); PGT[i] = 0.f; } }
            if (sub <= 1)
            for (int task = wave; task < 16; task += 8) {
                const int tgl = task >> 3, h = task & 7; const int tokl = 32 * tgl + j; const size_t tok = (size_t)tok0 + tokl;
                int L1[16], L2[16];
                peer_top16(QP + tok * D + h * 256 + 8 * hh, KEYS + ((size_t)(h * 2) * 128 + j) * 128 + 8 * hh, hh, L1);
                peer_top16(QP + tok * D + h * 256 + 128 + 8 * hh, KEYS + ((size_t)(h * 2 + 1) * 128 + j) * 128 + 8 * hh, hh, L2);
                float a1[16], a2[16];
#pragma unroll
                for (int i = 0; i < 16; ++i) { a1[i] = s2f(L1[i] & ~0x7f); a2[i] = s2f(L2[i] & ~0x7f); }
                int C0[16], C1[16], C2[16], C3[16];
#pragma unroll
                for (int i = 0; i < 16; ++i) { C0[i] = (int)0x80000000; C1[i] = (int)0x80000000; C2[i] = (int)0x80000000; C3[i] = (int)0x80000000; }
                { int n = 0;
#pragma unroll
                  for (int i = 0; i < 16; ++i)
#pragma unroll
                      for (int jj = 0; jj < 16; ++jj) if ((i + 1) * (jj + 1) <= 16) { const int v = (f2s(a1[i] + a2[jj]) & ~0xff) | (i << 4) | jj;
                          if (n < 16) C0[n & 15] = v; else if (n < 32) C1[n & 15] = v; else if (n < 48) C2[n & 15] = v; else C3[n & 15] = v; ++n; } }
                bitonic_sort16(C0); bitonic_sort16(C1); bitonic_sort16(C2); CEX(C3, 0, 1);
                merge_top16(C0, C1); merge_top16(C2, C3); merge_top16(C0, C2);
                int (&Lf)[16] = C0;
#pragma unroll
                for (int i = 0; i < 16; ++i) { KSEL[i * 512 + tid] = (unsigned char)(L1[i] & 0x7f); KSEL[8192 + i * 512 + tid] = (unsigned char)(L2[i] & 0x7f); }
                float sc16[16]; float sum = 0.f;
                const float smax = s2f(Lf[0] & ~0xff);
#pragma unroll
                for (int k = 0; k < 16; ++k) { sc16[k] = __expf(s2f(Lf[k] & ~0xff) - smax); sum += sc16[k]; }
                const float inv = 1.0f / sum;
                if (hh == 0) {
#pragma unroll
                    for (int k = 0; k < 16; ++k) { const int code = Lf[k] & 0xff; const int e = (int)KSEL[(code >> 4) * 512 + tid] * 128 + (int)KSEL[8192 + (code & 15) * 512 + tid];
                        PIDX[tokl * 128 + h * 16 + k] = (unsigned short)e; PGT[tokl * 128 + h * 16 + k] = sc16[k] * inv; }
                }
            }
#pragma unroll
            for (int i = 0; i < 16; ++i) AACC[wave * 1024 + i * 64 + lane] = 0.f;
            __syncthreads();
            if (sub == 0 || sub == 2)
            { const int ul = fresh_lane(); const int un = ul & 15, ukq = ul >> 4, uchi = ul & 3, urho = ul >> 2;
              const bool bon = ((ukq >> 1) == ((un >> 2) & 1)), bhi = (un >> 3) != 0;
              LAS unsigned char* XS = lds + 98304 + wave * 4096;
              u32x4 bufA[16], bufB[16]; u32x4 xr[4];
#pragma unroll
              for (int i = 0; i < 4; ++i) xr[i] = (u32x4){0u, 0u, 0u, 0u};
#define X_FETCH(rnd_) do { const int sl_ = (xcc + (rnd_)) & 7; const bf16_t* xp_ = XN + ((size_t)tok0 + wave * 8 + (ul >> 5)) * D + sl_ * 256 + (ul & 31) * 8; \
                  _Pragma("unroll") for (int i_ = 0; i_ < 4; ++i_) xr[i_] = *(const u32x4*)(xp_ + (size_t)(2 * i_) * D); } while (0)
#define X_PUT() do { LAS unsigned char* d_ = XS + (ul >> 5) * 256 + (ul & 31) * 8; _Pragma("unroll") for (int i_ = 0; i_ < 4; ++i_) { \
                      const f32x4 lo_ = (f32x4){bflo(xr[i_].x), bfhi(xr[i_].x), bflo(xr[i_].y), bfhi(xr[i_].y)} * XU_SCALE, hi_ = (f32x4){bflo(xr[i_].z), bfhi(xr[i_].z), bflo(xr[i_].w), bfhi(xr[i_].w)} * XU_SCALE; \
                      *(LAS u32x2*)(d_ + i_ * 512) = pack8_fp8(lo_, hi_); } } while (0)
#define U_LOAD(BUF, step_) do { const int r_ = (step_) >> 3, ti_ = (step_) & 7, sl_ = (xcc + r_) & 7, tokl_ = wave * 8 + ti_; \
                  const unsigned char* ub_ = U8 + (size_t)sl_ * SLICE; \
                  _Pragma("unroll") for (int g_ = 0; g_ < 8; ++g_) { const unsigned e_ = PIDX[tokl_ * 128 + 16 * g_ + urho]; \
                      BUF[2 * g_] = *(const u32x4*)(ub_ + (e_ * 128u + (unsigned)uchi * 16u)); BUF[2 * g_ + 1] = *(const u32x4*)(ub_ + (e_ * 128u + (unsigned)uchi * 16u + 64u)); } } while (0)
#define U_COMP(BUF, step_) do { const int ti_ = (step_) & 7, tokl_ = wave * 8 + ti_; \
                  const LAS unsigned char* xs_ = XS + ti_ * 256 + 32 * (un & 3) + 16 * (ukq & 1); u32x4 y0_ = (u32x4){0u, 0u, 0u, 0u}, y1_ = y0_; const u32x4 z_ = y0_; \
                  if (bon) { y0_ = *(const LAS u32x4*)(xs_); y1_ = *(const LAS u32x4*)(xs_ + 128); } \
                  const u32x4 x0_ = bhi ? z_ : y0_, x1_ = bhi ? y0_ : z_, x2_ = bhi ? z_ : y1_, x3_ = bhi ? y1_ : z_; \
                  const pg8::i32x8_t XB0 = (pg8::i32x8_t){(int)x0_.x, (int)x0_.y, (int)x0_.z, (int)x0_.w, (int)x1_.x, (int)x1_.y, (int)x1_.z, (int)x1_.w}, XB1 = (pg8::i32x8_t){(int)x2_.x, (int)x2_.y, (int)x2_.z, (int)x2_.w, (int)x3_.x, (int)x3_.y, (int)x3_.z, (int)x3_.w}; \
                  float vv_[8]; \
                  _Pragma("unroll") for (int g_ = 0; g_ < 8; ++g_) { f32x4 acc_ = (f32x4){0.f, 0.f, 0.f, 0.f}; \
                      const u32x4 a0_ = BUF[2 * g_], a1_ = BUF[2 * g_ + 1]; \
                      acc_ = __builtin_amdgcn_mfma_scale_f32_16x16x128_f8f6f4((pg8::i32x8_t){(int)a0_.x, (int)a0_.y, (int)a0_.z, (int)a0_.w, 0, 0, 0, 0}, XB0, acc_, 4, 0, 0, 0x7f7f7f7f, 0, 0x7f7f7f7f); \
                      acc_ = __builtin_amdgcn_mfma_scale_f32_16x16x128_f8f6f4((pg8::i32x8_t){(int)a1_.x, (int)a1_.y, (int)a1_.z, (int)a1_.w, 0, 0, 0, 0}, XB1, acc_, 4, 0, 0, 0x7f7f7f7f, 0, 0x7f7f7f7f); \
                      float v_ = (uchi == 0) ? acc_[0] : ((uchi == 1) ? acc_[1] : ((uchi == 2) ? acc_[2] : acc_[3])); \
                      v_ = quad_sum(v_); vv_[g_] = v_; } \
                  if (uchi == 0) { LAS float* p_ = AACC + tokl_ * 128 + 4 * (un >> 2) + ukq; float aa_[8];     \
                      _Pragma("unroll") for (int g_ = 0; g_ < 8; ++g_) aa_[g_] = p_[16 * g_]; \
                      _Pragma("unroll") for (int g_ = 0; g_ < 8; ++g_) p_[16 * g_] = aa_[g_] + vv_[g_]; } } while (0)
              X_FETCH(0); X_PUT();
              U_LOAD(bufA, 0);
              for (int step = 0; step < 64; step += 2) {
                  U_LOAD(bufB, step + 1);
                  if ((step & 7) == 2 && step + 8 < 64) X_FETCH((step >> 3) + 1);
                  U_COMP(bufA, step);
                  if (step + 2 < 64) U_LOAD(bufA, step + 2);
                  U_COMP(bufB, step + 1);
                  if ((step & 7) == 6 && step + 2 < 64) X_PUT();
              }
#undef X_FETCH
#undef X_PUT
#undef U_LOAD
#undef U_COMP
            }
            LAS unsigned char* CF = lds + 81920;
            float iscv = 0.f;
            if (sub == 0) { const int cl = fresh_lane();
                float us[16], vs[16]; u64 sq[8];
#pragma unroll
                for (int ti = 0; ti < 8; ++ti) { sq[ti] = SSQ2[(size_t)tok0 + wave * 8 + ti];
#pragma unroll
                    for (int k = 0; k < 2; ++k) { const unsigned e = PIDX[(wave * 8 + ti) * 128 + k * 64 + cl]; us[2 * ti + k] = USC[e]; vs[2 * ti + k] = VSC[e]; } }
#pragma unroll
                for (int ti = 0; ti < 8; ++ti) {
                    const int tokl = wave * 8 + ti;
                    const float rstd2 = stat_rstd(sq[ti], 1.0f / 2048.0f);
                    const int sl0 = tokl * 128 + cl, sl1 = sl0 + 64;
                    const f32x2 av = (f32x2){AACC[sl0] * us[2 * ti], AACC[sl1] * us[2 * ti + 1]} * (rstd2 * (1.0f / XU_SCALE));
                    const f32x2 ge = pg8::gelu_pk(av);
                    float cv[2]; cv[0] = PGT[sl0] * ge.x * vs[2 * ti] * P10SCALE; cv[1] = PGT[sl1] * ge.y * vs[2 * ti + 1] * P10SCALE;
                    const float m = wave_max(fmaxf(fabsf(cv[0]), fabsf(cv[1])));
                    const float sc = (m > 0.f) ? 448.0f / m : 1.0f;
                    if (cl == ti) iscv = (m > 0.f) ? m * (1.0f / 448.0f) : 1.0f;
#pragma unroll
                    for (int k = 0; k < 2; ++k) CF[tokl * 128 + k * 64 + cl] = (unsigned char)(__builtin_amdgcn_cvt_pk_fp8_f32(__builtin_amdgcn_fmed3f(cv[k] * sc, -448.0f, 448.0f), 0.f, 0, false) & 0xff);
                } }
            __syncthreads();
            if (sub == 0 || sub == 3)
            { const int vl = fresh_lane(); const int vr = vl & 15, vkq = vl >> 4;
              const unsigned lds0 = (unsigned)(size_t)lds;
              const unsigned bufw = (wave < 4) ? 16384u + (unsigned)wave * 16384u : 98304u + (unsigned)(wave - 4) * 16384u;
              const unsigned rbw = 90112u + (unsigned)wave * 1024u;
              const unsigned dch0 = (unsigned)((vl & 7) ^ (vl >> 4)) * 16u, dch1 = dch0 ^ 64u; const int dslot = vl >> 3;
              LAS unsigned char* const trb = lds + bufw + (unsigned)(32 * vkq + vr) * 128u; const unsigned fr = (unsigned)((vr >> 1) & 7);
              float* const outb = P10STORE ? args.out : (float*)(ws + WS_Z);
              typedef int v2i_t __attribute__((ext_vector_type(2)));
              float res[4] = {0.f, 0.f, 0.f, 0.f}; unsigned oprev = 0u;
#define V_GATHER(p_) do { const int sl_ = (xcc + ((p_) >> 3)) & 7; const unsigned char* vb_ = V8 + (size_t)sl_ * SLICE; const int tokl_ = wave * 8 + ((p_) & 7); \
                  _Pragma("unroll") for (int d_ = 0; d_ < 16; ++d_) { const unsigned e_ = PIDX[tokl_ * 128 + 8 * d_ + dslot]; \
                      glds16s((const void*)vb_, e_ * 128u + ((d_ & 1) ? dch1 : dch0), (unsigned)__builtin_amdgcn_readfirstlane((int)(lds0 + bufw + (unsigned)d_ * 1024u))); } } while (0)
#define V_RESID(p_) do { const int sl_ = (xcc + ((p_) >> 3)) & 7; const bf16_t* rb_ = XN + ((size_t)tok0 + wave * 8 + ((p_) & 7)) * D + sl_ * 256; \
                  if (vl < 32) glds16s((const void*)rb_, (unsigned)vl * 16u, (unsigned)__builtin_amdgcn_readfirstlane((int)(lds0 + rbw + (unsigned)((p_) & 1) * 512u))); } while (0)
#define V_STORE() do { asm volatile("s_nop 4\n\tglobal_store_dword %0, %1, %5 nt\n\tglobal_store_dword %0, %2, %5 offset:256 nt\n\tglobal_store_dword %0, %3, %5 offset:512 nt\n\tglobal_store_dword %0, %4, %5 offset:768 nt" \
                      :: "v"(oprev), "v"(res[0]), "v"(res[1]), "v"(res[2]), "v"(res[3]), "s"(outb) : "memory"); } while (0)
              V_GATHER(0); V_RESID(0);
#pragma unroll 1
              for (int p = 0; p < 64; ++p) {
                  asm volatile("s_waitcnt vmcnt(0)" ::: "memory");
                  const int tokl = wave * 8 + (p & 7);
                  u32x4 c0 = (u32x4){0u, 0u, 0u, 0u}, c1 = c0;
                  if ((vr & 3) == 0) { c0 = *(const LAS u32x4*)(CF + tokl * 128 + 16 * vkq); c1 = *(const LAS u32x4*)(CF + tokl * 128 + 16 * vkq + 64); }
                  v2i_t t0[16], t1[16];
#pragma unroll
                  for (int cb = 0; cb < 16; ++cb) { LAS unsigned char* q_ = trb + (((unsigned)(cb >> 1) ^ fr) * 16u) + 8 * (cb & 1);
                      t0[cb] = __builtin_amdgcn_ds_read_tr4_b64_v2i32((LAS v2i_t*)q_); t1[cb] = __builtin_amdgcn_ds_read_tr4_b64_v2i32((LAS v2i_t*)(q_ + 2048)); }
                  asm volatile("s_waitcnt lgkmcnt(0)" ::: "memory");
#pragma unroll
                  for (int cb = 0; cb < 16; ++cb) { asm volatile("" : "+v"(t0[cb]), "+v"(t1[cb])); }
                  if (p > 0) V_STORE();
                  if (p + 1 < 64) { V_GATHER(p + 1); V_RESID(p + 1); }
                  f32x4 acc[4];
#pragma unroll
                  for (int c = 0; c < 4; ++c) acc[c] = (f32x4){0.f, 0.f, 0.f, 0.f};
#pragma unroll
                  for (int g = 0; g < 4; ++g) { const bool on = (vr >> 2) == g;
                      const pg8::i32x8_t A = (pg8::i32x8_t){on ? (int)c0.x : 0, on ? (int)c0.y : 0, on ? (int)c0.z : 0, on ? (int)c0.w : 0, on ? (int)c1.x : 0, on ? (int)c1.y : 0, on ? (int)c1.z : 0, on ? (int)c1.w : 0};
#pragma unroll
                      for (int c = 0; c < 4; ++c) acc[c] = __builtin_amdgcn_mfma_scale_f32_16x16x128_f8f6f4(A, (pg8::i32x8_t){t0[4 * c + g].x, t0[4 * c + g].y, t1[4 * c + g].x, t1[4 * c + g].y, 0, 0, 0, 0}, acc[c], 0, 4, 0, 0x7f7f7f7f, 0, 0x7f7f7f7f); }
                  const float isc = __builtin_bit_cast(float, __builtin_amdgcn_readlane(__builtin_bit_cast(int, iscv), p & 7));
                  const int sl = (xcc + (p >> 3)) & 7; const LAS unsigned short* rb = (const LAS unsigned short*)(lds + rbw + (p & 1) * 512) + vl;
#pragma unroll
                  for (int c = 0; c < 4; ++c) res[c] = __builtin_bit_cast(float, (unsigned)rb[64 * c] << 16) + isc * acc[c][0];
                  oprev = (unsigned)(((size_t)tok0 + tokl) * D + sl * 256 + vl) * 4u;
              }
              V_STORE();
              asm volatile("s_waitcnt vmcnt(0)" ::: "memory");
#undef V_GATHER
#undef V_RESID
#undef V_STORE
            }
        }
    }
#undef IN
#undef SEAM
#undef GRID_BAR
}

extern "C" void kernel_launch(void* const* d_in, const int* in_sizes, int n_in, void* d_out, int out_size, void* d_ws, size_t ws_size, hipStream_t stream) {
    static int grid = 0;
    if (grid == 0) {
        if (n_in != 28 || out_size != T * D || ws_size < WS_END) { fprintf(stderr, "kernel_launch: unexpected problem (n_in %d, out %d, ws %zu)\n", n_in, out_size, ws_size); grid = -1; return; }
        int dev = 0, cus = 0;
        if (hipGetDevice(&dev) != hipSuccess || hipDeviceGetAttribute(&cus, hipDeviceAttributeMultiprocessorCount, dev) != hipSuccess) { grid = -1; return; }
        if (hipFuncSetAttribute((const void*)fwd_t<0>, hipFuncAttributeMaxDynamicSharedMemorySize, LDS_BYTES) != hipSuccess) { fprintf(stderr, "kernel_launch: hipFuncSetAttribute failed\n"); grid = -1; return; }
        int per_cu = 0;
        if (hipOccupancyMaxActiveBlocksPerMultiprocessor(&per_cu, (const void*)fwd_t<0>, 512, LDS_BYTES) != hipSuccess || per_cu < 1) { fprintf(stderr, "kernel_launch: occupancy query says %d\n", per_cu); }
        (void)hipGetLastError();
        grid = cus;
    }
    if (grid < 0) return;
    (void)hipMemsetAsync((char*)d_ws + WS_CTL, 0, CTL_BYTES, stream);
    Args a{};
    for (int i = 0; i < 28; ++i) a.in[i] = (const float*)d_in[i];
    a.out = (float*)d_out; a.ws = (unsigned char*)d_ws;
#if MK_SPLIT
    for (int p = 0; p < NPHASE; ++p) { a.ph_lo = p; a.ph_hi = p + 1; a.dup = 0; hipLaunchKernelGGL(fwd_t<0>, dim3(grid), dim3(512), LDS_BYTES, stream, a);
        if (p == DUP_PHASE) { a.dup = 1;
            if (DUP_PHASE == 10) { (void)hipFuncSetAttribute((const void*)fwd_t<0, (DUP_PHASE == 10 ? (DUP_SUB == 0 ? 4 : DUP_SUB) : 0)>, hipFuncAttributeMaxDynamicSharedMemorySize, LDS_BYTES); hipLaunchKernelGGL((fwd_t<0, (DUP_PHASE == 10 ? (DUP_SUB == 0 ? 4 : DUP_SUB) : 0)>), dim3(grid), dim3(512), LDS_BYTES, stream, a); }
            else if (DUP_PHASE == 3 && DUP_SUB != 0) { (void)hipFuncSetAttribute((const void*)fwd_t<(DUP_PHASE == 3 ? DUP_SUB : 0)>, hipFuncAttributeMaxDynamicSharedMemorySize, LDS_BYTES); hipLaunchKernelGGL(fwd_t<(DUP_PHASE == 3 ? DUP_SUB : 0)>, dim3(grid), dim3(512), LDS_BYTES, stream, a); }
            else hipLaunchKernelGGL(fwd_t<0>, dim3(grid), dim3(512), LDS_BYTES, stream, a);
            a.dup = 0; } }
#else
    a.ph_lo = 0; a.ph_hi = NPHASE;
    hipLaunchKernelGGL(fwd_t<0>, dim3(grid), dim3(512), LDS_BYTES, stream, a);
#endif
}
```
